# Optimizing an MI355X kernel written in HIP

```python
import jax, jax.numpy as jnp
from jax import lax
import numpy as np

D_MODEL = 1024
BATCH = 2
SEQ = 16384
DEPTH = 1
DEC_BATCH = 32
DEC_SEQ = 64
PAST_LEN = 1024

CHUNK = 64
D_MIX = D_MODEL
NH_M = 4
DH_M = D_MIX // 2 // NH_M
D_M = NH_M * DH_M
NH_A = 8
DH_A = (D_MIX - D_M) // NH_A
D_A = NH_A * DH_A
CONV_W = 4
LEFT_CHUNKS = 8
ATT_WINDOW = LEFT_CHUNKS * CHUNK
MAX_REL = 2 * CHUNK
N_REL = (CHUNK - 1) + MAX_REL + 1
D_FF = 2816
N_MOD = 9
EPS = 1e-6
OFF_MQ = 0
OFF_MK = D_M
OFF_MV = 2 * D_M
OFF_MO = 3 * D_M
OFF_MI = 4 * D_M
OFF_MF = 4 * D_M + NH_M
OFF_AQ = 4 * D_M + 2 * NH_M
OFF_AK = OFF_AQ + D_A
OFF_AV = OFF_AK + D_A
D_IN = OFF_AV + D_A

kernel_name = 'hybrid_mlstm_chunkband_stream_step'


def rmsnorm(x, g):
    xf = x.astype(jnp.float32)
    y = xf * lax.rsqrt(jnp.mean(xf * xf, axis=-1, keepdims=True) + EPS)
    return (y * g.astype(jnp.float32)).astype(x.dtype)


def adaln_params(c, w_ada, b_ada):
    mod = jnp.einsum('bd,de->be', jax.nn.silu(c), w_ada) + b_ada
    return jnp.split(mod[:, None, :], N_MOD, axis=-1)


def modulate(h, shift, scale):
    return h * (1 + scale) + shift


def swiglu(h, w_up, w_down):
    g, u = jnp.split(h @ w_up, 2, axis=-1)
    return (jax.nn.silu(g) * u) @ w_down


def half_ffn(x, shift, scale, gate, g, w_up, w_down):
    h = modulate(rmsnorm(x, g), shift, scale)
    return x + 0.5 * gate * swiglu(h, w_up, w_down)


def causal_conv(u, prev, w, b):
    L = u.shape[1]
    up = jnp.concatenate([prev.astype(u.dtype), u], axis=1)
    out = b + w[0] * up[:, 0:L]
    for j in range(1, CONV_W):
        out = out + w[j] * up[:, j:j + L]
    return jax.nn.silu(out), up[:, up.shape[1] - (CONV_W - 1):]


def project_in(h, w_in, conv_prev, conv_w, conv_b, b_gates):
    B, L, _ = h.shape
    proj = h @ w_in
    qk_m, conv_new = causal_conv(proj[..., OFF_MQ:OFF_MV], conv_prev, conv_w, conv_b)
    heads = lambda t, nh: t.astype(jnp.float32).reshape(B, L, nh, -1)
    mq = heads(qk_m[..., :D_M], NH_M)
    mk = heads(qk_m[..., D_M:], NH_M) * DH_M ** -0.5
    mv = heads(proj[..., OFF_MV:OFF_MO], NH_M)
    mo = proj[..., OFF_MO:OFF_MI]
    gates = proj[..., OFF_MI:OFF_AQ].astype(jnp.float32) + b_gates.astype(jnp.float32)
    ig, fg = gates[..., :NH_M], gates[..., NH_M:]
    aq = proj[..., OFF_AQ:OFF_AK].reshape(B, L, NH_A, DH_A)
    ak = proj[..., OFF_AK:OFF_AV].reshape(B, L, NH_A, DH_A)
    av = proj[..., OFF_AV:D_IN].reshape(B, L, NH_A, DH_A)
    return mq, mk, mv, mo, ig, fg, aq, ak, av, conv_new


def mlstm_chunk(state, q, k, v, ig, fg):
    C, n, m = state
    L = q.shape[2]
    b = jnp.cumsum(jax.nn.log_sigmoid(fg), axis=-1)
    causal = jnp.tril(jnp.ones((L, L), dtype=bool))
    log_w = jnp.where(causal, b[..., :, None] - b[..., None, :] + ig[..., None, :], -jnp.inf)
    log_inter = b + m[..., None]
    m_t = jnp.maximum(log_inter, jnp.max(log_w, axis=-1))
    w_inter = jnp.exp(log_inter - m_t)
    a = jnp.exp(log_w - m_t[..., None]) * jnp.einsum('bhtd,bhsd->bhts', q, k)
    num = w_inter[..., None] * jnp.einsum('bhte,bhed->bhtd', q, C) + jnp.einsum('bhts,bhsd->bhtd', a, v)
    den = w_inter * jnp.einsum('bhte,bhe->bht', q, n) + jnp.sum(a, axis=-1)
    h = num / jnp.maximum(jnp.abs(den), jnp.exp(-m_t))[..., None]
    b_end = b[..., -1]
    log_g = b_end[..., None] - b + ig
    m_end = jnp.maximum(b_end + m, jnp.max(log_g, axis=-1))
    decay = jnp.exp(b_end + m - m_end)
    g = jnp.exp(log_g - m_end[..., None])
    C_new = decay[..., None, None] * C + jnp.einsum('bhs,bhse,bhsd->bhed', g, k, v)
    n_new = decay[..., None] * n + jnp.einsum('bhs,bhse->bhe', g, k)
    return (C_new, n_new, m_end), h


def mlstm_prompt(q, k, v, ig, fg):
    B, S = q.shape[:2]
    nc = S // CHUNK
    def chunks(t):
        t = t.reshape((B, nc, CHUNK) + t.shape[2:])
        return jnp.moveaxis(jnp.moveaxis(t, 1, 0), 3, 2)
    init = (jnp.zeros((B, NH_M, DH_M, DH_M), jnp.float32),
            jnp.zeros((B, NH_M, DH_M), jnp.float32),
            jnp.zeros((B, NH_M), jnp.float32))
    state, h = lax.scan(lambda s, xs: mlstm_chunk(s, *xs), init,
                        (chunks(q), chunks(k), chunks(v), chunks(ig), chunks(fg)))
    h = jnp.transpose(h, (1, 0, 3, 2, 4)).reshape(B, S, NH_M, DH_M)
    return state, h


def rel_position_bias(rel_table, q_pos, k_pos):
    d = jnp.clip(q_pos[:, None] - k_pos[None, :], -(CHUNK - 1), MAX_REL) + (CHUNK - 1)
    return rel_table[:, d]


def band_attention(q, k, v, q_pos, k_pos, rel_table):
    qc, kc = q_pos // CHUNK, k_pos // CHUNK
    valid = (k_pos[None, :] >= 0) & (kc[None, :] <= qc[:, None]) & (kc[None, :] >= qc[:, None] - LEFT_CHUNKS)
    s = jnp.einsum('bqhd,bkhd->bhqk', q, k).astype(jnp.float32) * DH_A ** -0.5
    s = s + rel_position_bias(rel_table, q_pos, k_pos).astype(jnp.float32)
    s = jnp.where(valid, s, -jnp.inf)
    p = jax.nn.softmax(s, axis=-1).astype(v.dtype)
    return jnp.einsum('bhqk,bkhd->bqhd', p, v)


def attention_prompt(q, k, v, rel_table):
    B, S = q.shape[:2]
    nc = S // CHUNK
    band = ATT_WINDOW + CHUNK
    pad = ((0, 0), (ATT_WINDOW, 0), (0, 0), (0, 0))
    kp, vp = jnp.pad(k, pad), jnp.pad(v, pad)
    def one_chunk(ci):
        start = ci * CHUNK
        qn = lax.dynamic_slice_in_dim(q, start, CHUNK, axis=1)
        kn = lax.dynamic_slice_in_dim(kp, start, band, axis=1)
        vn = lax.dynamic_slice_in_dim(vp, start, band, axis=1)
        q_pos = start + jnp.arange(CHUNK)
        k_pos = start - ATT_WINDOW + jnp.arange(band)
        return band_attention(qn, kn, vn, q_pos, k_pos, rel_table)
    out = lax.map(one_chunk, jnp.arange(nc))
    return jnp.moveaxis(out, 0, 1).reshape(B, S, D_A)


def mixer_out(hm, mo, g_mlstm, att, w_out):
    B, L = hm.shape[:2]
    hn = hm * lax.rsqrt(jnp.mean(hm * hm, axis=-1, keepdims=True) + EPS)
    hn = hn.reshape(B, L, D_M) * g_mlstm.astype(jnp.float32)
    hm_out = (jax.nn.sigmoid(mo.astype(jnp.float32)) * hn).astype(att.dtype)
    return jnp.concatenate([hm_out, att], axis=-1) @ w_out


def run_layer(x, c, conv_prev, m_state, kv_cache, w_ada, b_ada, g_norm, w_ffn1_up, w_ffn1_down,
              w_ffn2_up, w_ffn2_down, w_in, conv_w, conv_b, b_gates, g_mlstm, rel_table, w_out):
    B, L, _ = x.shape
    sh1, sc1, gt1, sh2, sc2, gt2, sh3, sc3, gt3 = adaln_params(c, w_ada, b_ada)
    x = half_ffn(x, sh1, sc1, gt1, g_norm[0], w_ffn1_up, w_ffn1_down)
    h = modulate(rmsnorm(x, g_norm[1]), sh2, sc2)
    if conv_prev is None:
        conv_prev = jnp.zeros((B, CONV_W - 1, 2 * D_M), h.dtype)
    mq, mk, mv, mo, ig, fg, aq, ak, av, conv_new = project_in(h, w_in, conv_prev, conv_w, conv_b, b_gates)
    if kv_cache is None:
        m_new, hm = mlstm_prompt(mq, mk, mv, ig, fg)
        att = attention_prompt(aq, ak, av, rel_table)
        n_keep = min(ATT_WINDOW, L)
        k_new, v_new = ak[:, L - n_keep:], av[:, L - n_keep:]
    else:
        cache_k, cache_v = kv_cache
        to_bhl = lambda t: jnp.swapaxes(t, 1, 2)
        m_prev = tuple(s.astype(jnp.float32) for s in m_state)
        m_new, hm = mlstm_chunk(m_prev, to_bhl(mq), to_bhl(mk), to_bhl(mv), to_bhl(ig), to_bhl(fg))
        hm = to_bhl(hm)
        n_c = cache_k.shape[1]
        q_pos = PAST_LEN + jnp.arange(L)
        k_pos = jnp.concatenate([PAST_LEN - n_c + jnp.arange(n_c), q_pos])
        keys = jnp.concatenate([cache_k.astype(ak.dtype), ak], axis=1)
        vals = jnp.concatenate([cache_v.astype(av.dtype), av], axis=1)
        att = band_attention(aq, keys, vals, q_pos, k_pos, rel_table).reshape(B, L, D_A)
        k_new, v_new = ak, av
    x = x + gt2 * mixer_out(hm, mo, g_mlstm, att, w_out)
    x = half_ffn(x, sh3, sc3, gt3, g_norm[2], w_ffn2_up, w_ffn2_down)
    return x, m_new + (conv_new, k_new, v_new)


def setup_inputs(seed: int = 0) -> dict:
    key = jax.random.key(seed)
    ks = jax.random.split(key, 32)
    nrm = lambda k, shape, s: s * jax.random.normal(k, shape, jnp.float32)
    n_att = min(ATT_WINDOW, PAST_LEN)
    return {
        'x_prompt': nrm(ks[0], (BATCH, SEQ, D_MODEL), 1.0),
        'x_sample': nrm(ks[1], (DEC_BATCH, DEC_SEQ, D_MODEL), 1.0),
        'state_mlstm_C': nrm(ks[2], (DEPTH, DEC_BATCH, NH_M, DH_M, DH_M), 0.05),
        'state_mlstm_n': nrm(ks[3], (DEPTH, DEC_BATCH, NH_M, DH_M), 0.1),
        'state_mlstm_m': nrm(ks[4], (DEPTH, DEC_BATCH, NH_M), 1.0),
        'state_conv': nrm(ks[5], (DEPTH, DEC_BATCH, CONV_W - 1, 2 * D_M), 1.0),
        'cache_att_k': nrm(ks[6], (DEPTH, DEC_BATCH, n_att, NH_A, DH_A), 1.0),
        'cache_att_v': nrm(ks[7], (DEPTH, DEC_BATCH, n_att, NH_A, DH_A), 1.0),
        'c_prompt': nrm(ks[8], (BATCH, D_MODEL), 1.0),
        'c_sample': nrm(ks[9], (DEC_BATCH, D_MODEL), 1.0),
        'w_ada': nrm(ks[10], (DEPTH, D_MODEL, N_MOD * D_MODEL), 0.5 * D_MODEL ** -0.5),
        'b_ada': nrm(ks[11], (DEPTH, N_MOD * D_MODEL), 0.1),
        'g_norm': 1.0 + nrm(ks[12], (DEPTH, 3, D_MODEL), 0.1),
        'w_ffn1_up': nrm(ks[13], (DEPTH, D_MODEL, 2 * D_FF), D_MODEL ** -0.5),
        'w_ffn1_down': nrm(ks[14], (DEPTH, D_FF, D_MODEL), D_FF ** -0.5),
        'w_ffn2_up': nrm(ks[15], (DEPTH, D_MODEL, 2 * D_FF), D_MODEL ** -0.5),
        'w_ffn2_down': nrm(ks[16], (DEPTH, D_FF, D_MODEL), D_FF ** -0.5),
        'w_in': nrm(ks[17], (DEPTH, D_MODEL, D_IN), D_MODEL ** -0.5),
        'conv_w': nrm(ks[18], (DEPTH, CONV_W, 2 * D_M), CONV_W ** -0.5),
        'conv_b': nrm(ks[19], (DEPTH, 2 * D_M), 0.01),
        'b_gates': jnp.concatenate([nrm(ks[20], (DEPTH, NH_M), 0.1),
                                    3.0 + nrm(ks[21], (DEPTH, NH_M), 0.5)], axis=-1),
        'g_mlstm': 1.0 + nrm(ks[22], (DEPTH, D_M), 0.1),
        'rel_bias_table': nrm(ks[23], (DEPTH, NH_A, N_REL), 0.5),
        'w_out': nrm(ks[24], (DEPTH, D_MIX, D_MODEL), D_MIX ** -0.5),
        'g_final': 1.0 + nrm(ks[25], (D_MODEL,), 0.1),
    }


def reference(x_prompt, x_sample, state_mlstm_C, state_mlstm_n, state_mlstm_m, state_conv,
              cache_att_k, cache_att_v, c_prompt, c_sample, w_ada, b_ada, g_norm,
              w_ffn1_up, w_ffn1_down, w_ffn2_up, w_ffn2_down, w_in, conv_w, conv_b, b_gates,
              g_mlstm, rel_bias_table, w_out, g_final):
    xp, xs = x_prompt, x_sample
    st_p, st_s = [], []
    for l in range(DEPTH):
        w = (w_ada[l], b_ada[l], g_norm[l], w_ffn1_up[l], w_ffn1_down[l], w_ffn2_up[l], w_ffn2_down[l],
             w_in[l], conv_w[l], conv_b[l], b_gates[l], g_mlstm[l], rel_bias_table[l], w_out[l])
        xp, sp = run_layer(xp, c_prompt, None, None, None, *w)
        xs, ss = run_layer(xs, c_sample, state_conv[l],
                           (state_mlstm_C[l], state_mlstm_n[l], state_mlstm_m[l]),
                           (cache_att_k[l], cache_att_v[l]), *w)
        st_p.append(sp)
        st_s.append(ss)
    stk = lambda sts, i: jnp.stack([s[i] for s in sts])
    mlstm_C_prompt = stk(st_p, 0)
    mlstm_n_prompt = stk(st_p, 1)
    mlstm_m_prompt = stk(st_p, 2)
    conv_prompt = stk(st_p, 3)
    att_k_prompt = stk(st_p, 4)
    att_v_prompt = stk(st_p, 5)
    mlstm_C_sample = stk(st_s, 0)
    mlstm_n_sample = stk(st_s, 1)
    mlstm_m_sample = stk(st_s, 2)
    conv_sample = stk(st_s, 3)
    att_k_sample = stk(st_s, 4)
    att_v_sample = stk(st_s, 5)
    y_prompt = rmsnorm(xp, g_final)
    y_sample = rmsnorm(xs, g_final)
    return (y_prompt, y_sample, mlstm_C_prompt, mlstm_n_prompt, mlstm_m_prompt, conv_prompt,
            att_k_prompt, att_v_prompt, mlstm_C_sample, mlstm_n_sample, mlstm_m_sample, conv_sample,
            att_k_sample, att_v_sample)
```

```cpp
#include <hip/hip_runtime.h>
#include <hip/hip_cooperative_groups.h>
#include <cstdio>
#include <cstdint>
namespace cg = cooperative_groups;

#ifndef MK_MULTI
#define MK_MULTI 0
#ifndef DBG_NPH
#define DBG_NPH 14
#endif
#endif

#ifndef DBG_REP
#define DBG_REP -1
#endif
#define DI __device__ __forceinline__
#define LAS __attribute__((address_space(3)))
typedef unsigned short bf16_t;
typedef short bf16x8 __attribute__((ext_vector_type(8)));
typedef short s16x4 __attribute__((ext_vector_type(4)));
typedef float f32x4 __attribute__((ext_vector_type(4)));
typedef unsigned u32x4 __attribute__((ext_vector_type(4)));
typedef unsigned u32x2 __attribute__((ext_vector_type(2)));

constexpr int DM = 1024, SEQ = 16384, NB = 2, DECB = 32, DECS = 64;
constexpr int MP = NB * SEQ, MS = DECB * DECS, M = MP + MS;
constexpr int DFF = 2816, NUP = 2 * DFF, DIN = 3592, NPROJ = 3584, NMOD = 9 * DM;
constexpr int NGC = M / 64;
constexpr int PQ = 0, PK = 512, PV = 1024, PO = 1536, PAQ = 2048, PAK = 2560, PAV = 3072;
constexpr float EPS = 1e-6f;
constexpr float LOG2E = 1.4426950408889634f;
constexpr size_t OFF_Y = 0, OFF_C_P = (size_t)M * DM, OFF_N_P = OFF_C_P + 131072, OFF_M_P = OFF_N_P + 1024, OFF_CONV_P = OFF_M_P + 8,
                 OFF_AK_P = OFF_CONV_P + 6144, OFF_AV_P = OFF_AK_P + 524288, OFF_C_S = OFF_AV_P + 524288, OFF_N_S = OFF_C_S + 2097152,
                 OFF_M_S = OFF_N_S + 16384, OFF_CONV_S = OFF_M_S + 128, OFF_AK_S = OFF_CONV_S + 98304, OFF_AV_S = OFF_AK_S + 1048576,
                 OUT_TOTAL = OFF_AV_S + 1048576;
constexpr size_t MiB = 1u << 20;
constexpr size_t WS_PREVB = 512 * 1024;
constexpr size_t WS_MOD = 1 * MiB, WS_WUP1 = 3 * MiB, WS_WDN1 = 14 * MiB, WS_WUP2 = 20 * MiB, WS_WDN2 = 31 * MiB, WS_WIN = 37 * MiB, WS_WOUT = 44 * MiB,
                 WS_GATES = 46 * MiB, WS_CHK = 48 * MiB, WS_HN = 49 * MiB, WS_PROJ = 117 * MiB, WS_UT = 355 * MiB, WS_CST = 424 * MiB, WS_XS = 494 * MiB, WS_END = 510 * MiB;
static_assert(WS_HN + (size_t)M * DM * 2 <= WS_PROJ && WS_PROJ + (size_t)M * NPROJ * 2 <= WS_UT && WS_UT + (size_t)NGC * 4 * 129 * 128 * 2 <= WS_CST &&
              WS_CST + (size_t)NGC * 4 * 129 * 128 * 2 <= WS_XS && WS_XS + (size_t)2 * MS * DM * 4 <= WS_END, "ws map");
constexpr int LDS_BYTES = 147456;
constexpr int TAB_OFF = 131072;
constexpr int BAR_LDS_OFF = LDS_BYTES - 64;
constexpr size_t CTL_ZERO_BYTES = 512 * 1024;
constexpr size_t CTL_SSQ_A = 64 * 1024, CTL_SSQ_B = 192 * 1024, CTL_CNT_A = 320 * 1024, CTL_CNT_B = 336 * 1024;

typedef float f32x2_t __attribute__((ext_vector_type(2))); typedef __bf16 bf16x2_t __attribute__((ext_vector_type(2)));
DI unsigned cvt_pk_bf16(float lo, float hi) { f32x2_t v = {lo, hi}; bf16x2_t b = __builtin_convertvector(v, bf16x2_t); return __builtin_bit_cast(unsigned, b); }
DI unsigned cvt_pk_asm(float lo, float hi) { unsigned r; asm volatile("v_cvt_pk_bf16_f32 %0, %1, %2" : "=v"(r) : "v"(lo), "v"(hi)); return r; }
DI float bf2f(unsigned short h) { return __uint_as_float((unsigned)h << 16); }
DI float bflo(unsigned w) { return __uint_as_float(w << 16); }
DI float bfhi(unsigned w) { return __uint_as_float(w & 0xffff0000u); }
DI float wave_sum(float v) {
#pragma unroll
    for (int o = 1; o < 64; o <<= 1) v += __shfl_xor(v, o);
    return v;
}
DI float wave_max(float v) {
#pragma unroll
    for (int o = 1; o < 64; o <<= 1) v = fmaxf(v, __shfl_xor(v, o));
    return v;
}
DI int modrow(int row) { return row < MP ? (row >> 14) : 2 + ((row - MP) >> 6); }
DI float fexp2(float x) { return __builtin_amdgcn_exp2f(x); }
DI float fexp(float x) { return __builtin_amdgcn_exp2f(x * 1.4426950408889634f); }
DI float frcp(float x) { return __builtin_amdgcn_rcpf(x); }
DI float sigmoidf_(float x) { return frcp(1.0f + fexp(-x)); }
DI float siluf_(float x) { return x * frcp(1.0f + fexp(-x)); }
#define MFMA16(a, b, c) __builtin_amdgcn_mfma_f32_16x16x32_bf16((a), (b), (c), 0, 0, 0)

namespace pg8 {
constexpr int BM = 256, BK = 64, HALF = 128, HTB = HALF * BK * 2, STAGE_BYTES = 8 * HTB, NXCD = 8, WGM = 8;
DI int lds_byte(int r, int c) { const int st = (r >> 4) * 2 + (c >> 5), rr = r & 15, cc = c & 31, ob = rr * 64 + cc * 2; return st * 1024 + (ob ^ (((ob >> 9) & 1) << 5)); }
DI void stage_rc(int b, int& R, int& C) { const int st = b / 1024, sb = b % 1024, swz = sb ^ (((sb >> 9) & 1) << 5); R = (st >> 1) * 16 + swz / 64; C = (st & 1) * 32 + (swz % 64) / 2; }
DI int perm32(int rho) { const int n = rho >> 4, i = rho & 15; return 8 * (i >> 2) + 4 * n + (i & 3); }
struct Unit { int pm, pn, k0, nt, part; };
struct Gemm { const bf16_t* A; const bf16_t* Bt; int M, N, K; };
struct StaticOrder {
    int nM, nN, nwg, G, c, ntk;
    DI void init(int M_, int N_, int G_, int c_, int K_) { nM = M_ / BM; nN = N_ / BM; nwg = nM * nN; G = G_; c = c_; ntk = K_ / BK; }
    DI void calc(int wg, int& pm, int& pn) const {
        int wgid = wg; { const int q = nwg / NXCD, r = nwg % NXCD, xcd = wgid % NXCD, off = wgid / NXCD; wgid = (xcd < r ? xcd * (q + 1) : r * (q + 1) + (xcd - r) * q) + off; }
        const int nig = WGM * nN, gid = wgid / nig, fm = gid * WGM, gsz = (nM - fm) < WGM ? (nM - fm) : WGM;
        pm = fm + ((wgid % nig) % gsz); pn = (wgid % nig) / gsz;
    }
    DI bool next(int i, Unit& u) const {
        const long L = (long)i * G + c; if (L >= nwg) return false;
        int wgid = (int)L; { const int q = nwg / NXCD, r = nwg % NXCD, xcd = wgid % NXCD, off = wgid / NXCD; wgid = (xcd < r ? xcd * (q + 1) : r * (q + 1) + (xcd - r) * q) + off; }
        const int nig = WGM * nN, gid = wgid / nig, fm = gid * WGM, gsz = (nM - fm) < WGM ? (nM - fm) : WGM;
        u.pm = fm + ((wgid % nig) % gsz); u.pn = (wgid % nig) / gsz; u.k0 = 0; u.nt = ntk; u.part = -1; return true;
    }
    DI void a_ready(const Unit&) const {}
    DI void done(const Unit&) const {}
};

struct SplitOrder {
    StaticOrder P; int NS, q1, q3;
    DI void init(int N_, int G_, int c_, int K_, int NS_) { P.init(MP, N_, G_, c_, K_); NS = NS_; const int nt = K_ / BK;
        if (NS_ == 4) { q1 = ((nt / 4) + 1) & ~1; q3 = 2 * q1 + (((nt - 2 * q1) / 2) & ~1); } else { q1 = nt / 2; q3 = nt; } }
    DI bool next(int i, Unit& u) const {
        const long L = (long)i * P.G + P.c;
        const int per = (MS / BM) * P.nN, total = P.nwg + NS * per;
        const bool isp = L < P.nwg;
        const int Lc = (int)(L < total ? L : total - 1);
        int ppm, ppn; P.calc(isp ? Lc : 0, ppm, ppn);
        const int j = isp ? 0 : Lc - P.nwg, part = j / per, rem = j % per;
        const int b = part == 3 ? q3 : part * q1;
        const int e = part == NS - 1 ? P.ntk : (part == 2 ? q3 : (part + 1) * q1);
        u.pm = isp ? ppm : MP / BM + rem / P.nN; u.pn = isp ? ppn : rem % P.nN; u.part = isp ? -1 : part; u.k0 = isp ? 0 : b; u.nt = isp ? P.ntk : e - b;
        return L < total;
    }
    DI void a_ready(const Unit&) const {}
    DI void done(const Unit&) const {}
};


struct EpiSwiglu {
    static constexpr bool PERM = true, AFTER_DRAIN = false;
    bf16_t* O;
    DI void operator()(const f32x4 (&acc)[2][2][4][2], const Unit& u, int wr, int wc, int fr, int fq) const {
        const int row0 = u.pm * BM + wr * 64 + fr, col0 = u.pn * HALF + wc * 32 + 8 * fq;
#pragma unroll
        for (int ai = 0; ai < 2; ++ai)
#pragma unroll
            for (int m = 0; m < 4; ++m) {
                bf16_t* p = O + (size_t)(row0 + ai * HALF + m * 16) * DFF + col0;
                f32x4 o4[2];
#pragma unroll
                for (int n = 0; n < 2; ++n) {
                    const f32x4 g4 = acc[ai][0][m][n], u4 = acc[ai][1][m][n];
                    const f32x4 t = g4 * (-LOG2E);
                    f32x4 e; e[0] = __builtin_amdgcn_exp2f(t[0]); e[1] = __builtin_amdgcn_exp2f(t[1]); e[2] = __builtin_amdgcn_exp2f(t[2]); e[3] = __builtin_amdgcn_exp2f(t[3]);
                    const f32x4 d = e + 1.0f;
                    f32x4 r; r[0] = __builtin_amdgcn_rcpf(d[0]); r[1] = __builtin_amdgcn_rcpf(d[1]); r[2] = __builtin_amdgcn_rcpf(d[2]); r[3] = __builtin_amdgcn_rcpf(d[3]);
                    o4[n] = (g4 * u4) * r;
                }
                u32x4 w; w.x = cvt_pk_asm(o4[0][0], o4[0][1]); w.y = cvt_pk_asm(o4[0][2], o4[0][3]); w.z = cvt_pk_asm(o4[1][0], o4[1][1]); w.w = cvt_pk_asm(o4[1][2], o4[1][3]);
                *(u32x4*)p = w;
            }
    }
};
template <bool B16IN>
struct EpiResidT {
    static constexpr bool PERM = true, AFTER_DRAIN = false;
    const float* base_f; const bf16_t* base_h; bf16_t* out_h; const float* mod; int gate_off; float coef; float* part;
    DI void operator()(const f32x4 (&acc)[2][2][4][2], const Unit& u, int wr, int wc, int fr, int fq) const {
        const int row0 = u.pm * BM + wr * 64 + fr, col0 = u.pn * BM + wc * 32 + 8 * fq;
        if (u.part >= 0) {
#pragma unroll
            for (int ai = 0; ai < 2; ++ai)
#pragma unroll
                for (int m = 0; m < 4; ++m) {
                    float* op = part + ((size_t)u.part * MS + (size_t)(row0 + ai * HALF + m * 16 - MP)) * DM;
#pragma unroll
                    for (int bj = 0; bj < 2; ++bj)
#pragma unroll
                        for (int n = 0; n < 2; ++n) *(f32x4*)(op + col0 + bj * HALF + 4 * n) = acc[ai][bj][m][n];
                }
            return;
        }
#pragma unroll
        for (int ai = 0; ai < 2; ++ai)
#pragma unroll
            for (int m = 0; m < 4; ++m) {
                const int row = row0 + ai * HALF + m * 16;
                const float* gp = mod + (size_t)(row >> 14) * NMOD + gate_off;
#pragma unroll
                for (int bj = 0; bj < 2; ++bj) {
                    const int c = col0 + bj * HALF;
                    f32x4 b0, b1;
                    if (B16IN) { const u32x4 w = *(const u32x4*)(base_h + (size_t)row * DM + c);
                        b0 = (f32x4){bflo(w.x), bfhi(w.x), bflo(w.y), bfhi(w.y)}; b1 = (f32x4){bflo(w.z), bfhi(w.z), bflo(w.w), bfhi(w.w)}; }
                    else { b0 = *(const f32x4*)(base_f + (size_t)row * DM + c); b1 = *(const f32x4*)(base_f + (size_t)row * DM + c + 4); }
                    const f32x4 g0 = *(const f32x4*)(gp + c), g1 = *(const f32x4*)(gp + c + 4);
                    const f32x4 o0 = b0 + (g0 * coef) * acc[ai][bj][m][0], o1 = b1 + (g1 * coef) * acc[ai][bj][m][1];
                    u32x4 w; w.x = cvt_pk_asm(o0[0], o0[1]); w.y = cvt_pk_asm(o0[2], o0[3]); w.z = cvt_pk_asm(o1[0], o1[1]); w.w = cvt_pk_asm(o1[2], o1[3]);
                    *(u32x4*)(out_h + (size_t)row * DM + c) = w;
                }
            }
    }
};
template <int MODE>
struct EpiResidNorm {
    static constexpr bool PERM = true, AFTER_DRAIN = false;
    const bf16_t* base_h; bf16_t* out_h; void* dst; const float* mod; float* part; const float* g; unsigned char* ctl;
    static constexpr int gate_off = MODE == 0 ? 8 * DM : 5 * DM, shift_off = 6 * DM, scale_off = 7 * DM;
    static constexpr float coef = MODE == 0 ? 0.5f : 1.0f;
    DI void operator()(const f32x4 (&acc)[2][2][4][2], const Unit& u, int wr, int wc, int fr, int fq) const {
        float* sumsq = (float*)(ctl + (MODE == 0 ? CTL_SSQ_B : CTL_SSQ_A)); unsigned* cnt = (unsigned*)(ctl + (MODE == 0 ? CTL_CNT_B : CTL_CNT_A));
        float* y = (float*)dst; bf16_t* hn = (bf16_t*)dst;
        const int row0 = u.pm * BM + wr * 64 + fr, col0 = u.pn * BM + wc * 32 + 8 * fq;
        if (u.part >= 0) {
#pragma unroll
            for (int ai = 0; ai < 2; ++ai)
#pragma unroll
                for (int m = 0; m < 4; ++m) {
                    float* op = part + ((size_t)u.part * MS + (size_t)(row0 + ai * HALF + m * 16 - MP)) * DM;
#pragma unroll
                    for (int bj = 0; bj < 2; ++bj)
#pragma unroll
                        for (int n = 0; n < 2; ++n) *(f32x4*)(op + col0 + bj * HALF + 4 * n) = acc[ai][bj][m][n];
                }
            return;
        }
        const float* md = mod + (size_t)(row0 >> 14) * NMOD;
        const unsigned rb = (unsigned)(row0 * DM + col0);
        float ssq[8];
#pragma unroll
        for (int k = 0; k < 8; ++k) ssq[k] = 0.f;
#pragma unroll
        for (int bj = 0; bj < 2; ++bj) {
            const int c = col0 + bj * HALF;
            const f32x4 g0 = *(const f32x4*)(md + gate_off + c) * coef, g1 = *(const f32x4*)(md + gate_off + c + 4) * coef;
#pragma unroll
            for (int ai = 0; ai < 2; ++ai)
#pragma unroll
                for (int m = 0; m < 4; ++m) {
                    const unsigned eo = rb + (unsigned)((ai * HALF + m * 16) * DM + bj * HALF);
                    const u32x4 w = *(const u32x4*)((const char*)base_h + eo * 2u);
                    const f32x4 b0 = {bflo(w.x), bfhi(w.x), bflo(w.y), bfhi(w.y)}, b1 = {bflo(w.z), bfhi(w.z), bflo(w.w), bfhi(w.w)};
                    const f32x4 x0 = b0 + g0 * acc[ai][bj][m][0], x1 = b1 + g1 * acc[ai][bj][m][1];
                    ssq[ai * 4 + m] += (x0[0] * x0[0] + x0[1] * x0[1]) + (x0[2] * x0[2] + x0[3] * x0[3]) + (x1[0] * x1[0] + x1[1] * x1[1]) + (x1[2] * x1[2] + x1[3] * x1[3]);
                    u32x4 p; p.x = cvt_pk_bf16(x0[0], x0[1]); p.y = cvt_pk_bf16(x0[2], x0[3]); p.z = cvt_pk_bf16(x1[0], x1[1]); p.w = cvt_pk_bf16(x1[2], x1[3]);
                    *(u32x4*)((char*)out_h + eo * 2u) = p;
                }
        }
#pragma unroll
        for (int k = 0; k < 8; ++k) { float s = ssq[k]; s += __shfl_xor(s, 16); s += __shfl_xor(s, 32); ssq[k] = s; }
        if (fq == 0) {
#pragma unroll
            for (int k = 0; k < 8; ++k) (void)__hip_atomic_fetch_add(sumsq + row0 + (k >> 2) * HALF + (k & 3) * 16, ssq[k], __ATOMIC_RELAXED, __HIP_MEMORY_SCOPE_AGENT);
        }
        asm volatile("s_waitcnt vmcnt(0)" ::: "memory");
        unsigned* cw = cnt + 16 * u.pm;
        if (fq == 0 && fr == 0) (void)__hip_atomic_fetch_add(cw, 1u, __ATOMIC_RELAXED, __HIP_MEMORY_SCOPE_AGENT);
        if (MODE == 2) return;
        { unsigned sp = 0; while ((unsigned)__builtin_amdgcn_readfirstlane(__hip_atomic_load(cw, __ATOMIC_RELAXED, __HIP_MEMORY_SCOPE_AGENT)) < 32u) { __builtin_amdgcn_s_sleep(2); if (++sp > (1u << 20)) break; } }
        asm volatile("" ::: "memory");
        float rstd[8];
#pragma unroll
        for (int k = 0; k < 8; ++k) { const float t = __hip_atomic_load(sumsq + row0 + (k >> 2) * HALF + (k & 3) * 16, __ATOMIC_RELAXED, __HIP_MEMORY_SCOPE_AGENT); rstd[k] = __builtin_amdgcn_rsqf(t * (1.0f / DM) + EPS); }
#pragma unroll
        for (int bj = 0; bj < 2; ++bj) {
            const int c = col0 + bj * HALF;
            f32x4 A0 = *(const f32x4*)(g + c), A1 = *(const f32x4*)(g + c + 4), B0 = {0.f, 0.f, 0.f, 0.f}, B1 = {0.f, 0.f, 0.f, 0.f};
            if (MODE == 1) { A0 = A0 * (*(const f32x4*)(md + scale_off + c) + 1.0f); A1 = A1 * (*(const f32x4*)(md + scale_off + c + 4) + 1.0f); B0 = *(const f32x4*)(md + shift_off + c); B1 = *(const f32x4*)(md + shift_off + c + 4); }
#pragma unroll
            for (int ai = 0; ai < 2; ++ai)
#pragma unroll
                for (int m = 0; m < 4; ++m) {
                    const unsigned eo = rb + (unsigned)((ai * HALF + m * 16) * DM + bj * HALF); const float rs = rstd[ai * 4 + m];
                    const u32x4 p = *(const u32x4*)((const char*)out_h + eo * 2u);
                    const f32x4 x0 = {bflo(p.x), bfhi(p.x), bflo(p.y), bfhi(p.y)}, x1 = {bflo(p.z), bfhi(p.z), bflo(p.w), bfhi(p.w)};
                    if (MODE == 0) {
                        *(f32x4*)((char*)y + eo * 4u) = (x0 * rs) * A0; *(f32x4*)((char*)y + eo * 4u + 16u) = (x1 * rs) * A1;
                    } else {
                        const f32x4 h0 = (x0 * rs) * A0 + B0, h1 = (x1 * rs) * A1 + B1;
                        u32x4 v; v.x = cvt_pk_bf16(h0[0], h0[1]); v.y = cvt_pk_bf16(h0[2], h0[3]); v.z = cvt_pk_bf16(h1[0], h1[1]); v.w = cvt_pk_bf16(h1[2], h1[3]);
                        *(u32x4*)((char*)hn + eo * 2u) = v;
                    }
                }
        }
    }
};
struct EpiProj {
    static constexpr bool PERM = true, AFTER_DRAIN = false;
    bf16_t* P; float* dout;
    DI void operator()(const f32x4 (&acc)[2][2][4][2], const Unit& u, int wr, int wc, int fr, int fq) const {
        const int row0 = u.pm * BM + wr * 64 + fr, col0 = u.pn * BM + wc * 32 + 8 * fq;
#pragma unroll
        for (int ai = 0; ai < 2; ++ai)
#pragma unroll
            for (int m = 0; m < 4; ++m) {
                const int row = row0 + ai * HALF + m * 16;
#pragma unroll
                for (int bj = 0; bj < 2; ++bj) {
                    const int col = col0 + bj * HALF;
                    const f32x4 v0 = acc[ai][bj][m][0], v1 = acc[ai][bj][m][1];
                    u32x4 w; w.x = cvt_pk_asm(v0[0], v0[1]); w.y = cvt_pk_asm(v0[2], v0[3]); w.z = cvt_pk_asm(v1[0], v1[1]); w.w = cvt_pk_asm(v1[2], v1[3]);
                    *(u32x4*)(P + (size_t)row * NPROJ + col) = w;
                    float* dst = nullptr;
                    if (col < 1024) {
                        if (row < MP) { const int t = row & (SEQ - 1); if (t >= SEQ - 3) dst = dout + OFF_CONV_P + (size_t)((row >> 14) * 3 + (t - (SEQ - 3))) * 1024 + col; }
                        else { const int t = (row - MP) & 63; if (t >= 61) dst = dout + OFF_CONV_S + (size_t)(((row - MP) >> 6) * 3 + (t - 61)) * 1024 + col; }
                    } else if (col >= PAK) {
                        const bool isv = col >= PAV; const int cc = col - (isv ? PAV : PAK);
                        if (row < MP) { const int t = row & (SEQ - 1); if (t >= SEQ - 512) dst = dout + (isv ? OFF_AV_P : OFF_AK_P) + (size_t)((row >> 14) * 512 + (t - (SEQ - 512))) * 512 + cc; }
                        else dst = dout + (isv ? OFF_AV_S : OFF_AK_S) + (size_t)(row - MP) * 512 + cc;
                    }
                    if (dst) { *(f32x4*)dst = v0; *(f32x4*)(dst + 4) = v1; }
                }
            }
    }
};

template <class Epi, class Sched, bool ALIGN_EPI = false, bool SP2 = false>
DI void gemm_phase(LAS unsigned char* lds, const Gemm g, const Sched& S, const Epi& E) {
    const int tid = threadIdx.x, wid = __builtin_amdgcn_readfirstlane(tid >> 6), lane = tid & 63, wr = wid >> 2, wc = wid & 3, fr = lane & 15, fq = lane >> 4;
    const int K = g.K;
    unsigned voffA[2], voffB[2];
#pragma unroll
    for (int i = 0; i < 2; ++i) { int R, C; stage_rc(tid * 16 + i * 8192, R, C); const int Rb = Epi::PERM ? ((R & ~31) + perm32(R & 31)) : R;
        voffA[i] = (unsigned)(R * K + C) * 2u; voffB[i] = (unsigned)(Rb * K + C) * 2u; }
    const size_t kstep = (size_t)(BK * 2);
    const size_t hstep = (size_t)HALF * K * 2;
    const size_t tstep = 2 * hstep;
    const unsigned ldsw = (unsigned)wid * 1024u;
    const int aoff = lds_byte(wr * 64 + fr, fq * 8), boff = lds_byte(wc * 32 + fr, fq * 8);
#define PG8_SA(b, h) (((b) * 2 + (h)) * HTB)
#define PG8_SB(b, h) ((4 + (b) * 2 + (h)) * HTB)
#define PG8_STAGE(bufoff, gbase, voff) do { _Pragma("unroll") for (int _i = 0; _i < 2; ++_i) \
        __builtin_amdgcn_global_load_lds((const unsigned*)((const char*)(gbase) + (voff)[_i]), (LAS unsigned*)(lds + (bufoff) + ldsw + _i * 8192), 16, 0, 0); } while (0)
#define PG8_LDA(dst, b, h) do { _Pragma("unroll") for (int m = 0; m < 4; ++m) _Pragma("unroll") for (int k = 0; k < 2; ++k) dst[m][k] = *(const LAS bf16x8*)(lds + PG8_SA(b, h) + aoff + m * 2048 + k * 1024); } while (0)
#define PG8_LDB(dst, b, h) do { _Pragma("unroll") for (int n = 0; n < 2; ++n) _Pragma("unroll") for (int k = 0; k < 2; ++k) dst[n][k] = *(const LAS bf16x8*)(lds + PG8_SB(b, h) + boff + n * 2048 + k * 1024); } while (0)
#define PG8_MMA(ai, bj, At, Bt) do { __builtin_amdgcn_s_setprio(1); _Pragma("unroll") for (int m = 0; m < 4; ++m) _Pragma("unroll") for (int n = 0; n < 2; ++n) _Pragma("unroll") for (int k = 0; k < 2; ++k) \
        acc[ai][bj][m][n] = __builtin_amdgcn_mfma_f32_16x16x32_bf16(Bt[n][k], At[m][k], acc[ai][bj][m][n], 0, 0, 0); __builtin_amdgcn_s_setprio(0); } while (0)
#define PG8_WAIT_V(n) asm volatile("s_waitcnt vmcnt(" #n ")" ::: "memory")
#define PG8_WAIT_L(n) asm volatile("s_waitcnt lgkmcnt(" #n ")" ::: "memory")
#define PG8_BAR __builtin_amdgcn_s_barrier()
#define PG8_SCHED __builtin_amdgcn_sched_barrier(0)
    Unit cur, nxt; int ui = 0;
    if (!S.next(0, cur)) return;
    f32x4 acc[2][2][4][2];
#pragma unroll
    for (int a = 0; a < 2; ++a)
#pragma unroll
        for (int b = 0; b < 2; ++b)
#pragma unroll
            for (int m = 0; m < 4; ++m)
#pragma unroll
                for (int n = 0; n < 2; ++n) acc[a][b][m][n] = (f32x4){0.f, 0.f, 0.f, 0.f};
    bf16x8 At[4][2], B0[2][2], B1[2][2];
    const char* cA = (const char*)g.A + (size_t)cur.pm * tstep + (size_t)cur.k0 * kstep; const char* cB = (const char*)g.Bt + (size_t)cur.pn * tstep + (size_t)cur.k0 * kstep;
    S.a_ready(cur);
    if constexpr (SP2) {
        PG8_STAGE(PG8_SB(0, 0), cB, voffB); PG8_STAGE(PG8_SB(0, 1), cB + hstep, voffB); PG8_STAGE(PG8_SA(0, 0), cA, voffA); PG8_STAGE(PG8_SA(0, 1), cA + hstep, voffA);
        if (wr == 1) PG8_BAR;
        PG8_WAIT_V(2); PG8_BAR;
        PG8_STAGE(PG8_SB(1, 0), cB + kstep, voffB); PG8_STAGE(PG8_SA(1, 0), cA + kstep, voffA); PG8_STAGE(PG8_SB(1, 1), cB + hstep + kstep, voffB);
        PG8_WAIT_V(6); PG8_BAR;
    } else {
        PG8_STAGE(PG8_SB(0, 0), cB, voffB); PG8_STAGE(PG8_SA(0, 0), cA, voffA); PG8_STAGE(PG8_SB(0, 1), cB + hstep, voffB); PG8_STAGE(PG8_SA(0, 1), cA + hstep, voffA);
        if (wr == 1) PG8_BAR;
        PG8_WAIT_V(4); PG8_BAR;
        PG8_STAGE(PG8_SB(1, 0), cB + kstep, voffB); PG8_STAGE(PG8_SA(1, 0), cA + kstep, voffA); PG8_STAGE(PG8_SB(1, 1), cB + hstep + kstep, voffB);
        PG8_WAIT_V(6); PG8_BAR;
    }
    for (;;) {
        const bool has_next = S.next(ui + 1, nxt);
        const char* nA = has_next ? (const char*)g.A + (size_t)nxt.pm * tstep + (size_t)nxt.k0 * kstep : cA; const char* nB = has_next ? (const char*)g.Bt + (size_t)nxt.pn * tstep + (size_t)nxt.k0 * kstep : cB;
        const int nt = cur.nt;
        for (int t = 0; t < nt; t += 2) {
            const bool last = (t == nt - 2);
            const char* a1 = cA + (size_t)(t + 1) * kstep;
            const char* a2 = last ? nA : cA + (size_t)(t + 2) * kstep; const char* b2 = last ? nB : cB + (size_t)(t + 2) * kstep;
            const char* a3 = a2 + kstep; const char* b3 = b2 + kstep;
            if (last && has_next) S.a_ready(nxt);
            if constexpr (SP2) {
            PG8_LDB(B0, 0, 0); PG8_LDB(B1, 0, 1); PG8_SCHED; PG8_LDA(At, 0, 0); PG8_STAGE(PG8_SA(1, 1), a1 + hstep, voffA);
            PG8_WAIT_V(8); PG8_WAIT_L(0); PG8_BAR; PG8_MMA(0, 0, At, B0); PG8_MMA(0, 1, At, B1); PG8_BAR; PG8_SCHED;
            PG8_LDA(At, 0, 1); PG8_STAGE(PG8_SB(0, 0), b2, voffB); PG8_STAGE(PG8_SB(0, 1), b2 + hstep, voffB); PG8_STAGE(PG8_SA(0, 0), a2, voffA);
            PG8_WAIT_V(8); PG8_WAIT_L(0); PG8_BAR; PG8_MMA(1, 0, At, B0); PG8_MMA(1, 1, At, B1); PG8_BAR; PG8_SCHED;
            PG8_LDB(B0, 1, 0); PG8_LDB(B1, 1, 1); PG8_SCHED; PG8_LDA(At, 1, 0); PG8_STAGE(PG8_SA(0, 1), a2 + hstep, voffA);
            PG8_WAIT_V(8); PG8_WAIT_L(0); PG8_BAR; PG8_MMA(0, 0, At, B0); PG8_MMA(0, 1, At, B1); PG8_BAR; PG8_SCHED;
            PG8_LDA(At, 1, 1); PG8_STAGE(PG8_SB(1, 0), b3, voffB); PG8_STAGE(PG8_SB(1, 1), b3 + hstep, voffB); PG8_STAGE(PG8_SA(1, 0), a3, voffA);
            PG8_WAIT_V(8); PG8_WAIT_L(0); PG8_BAR; PG8_MMA(1, 0, At, B0); PG8_MMA(1, 1, At, B1); PG8_BAR; PG8_SCHED;
            } else {
            PG8_LDB(B0, 0, 0); PG8_SCHED; PG8_LDA(At, 0, 0); PG8_STAGE(PG8_SA(1, 1), a1 + hstep, voffA);
            PG8_WAIT_L(8); PG8_BAR; PG8_WAIT_L(0); PG8_MMA(0, 0, At, B0); PG8_BAR; PG8_SCHED;
            PG8_LDB(B1, 0, 1); PG8_STAGE(PG8_SB(0, 0), b2, voffB);
            PG8_BAR; PG8_WAIT_L(0); PG8_MMA(0, 1, At, B1); PG8_BAR;
            PG8_LDA(At, 0, 1); PG8_STAGE(PG8_SA(0, 0), a2, voffA);
            PG8_BAR; PG8_WAIT_L(0); PG8_MMA(1, 0, At, B0); PG8_BAR; PG8_SCHED;
            PG8_STAGE(PG8_SB(0, 1), b2 + hstep, voffB);
            PG8_WAIT_V(6); PG8_BAR; PG8_MMA(1, 1, At, B1); PG8_BAR;
            PG8_LDB(B0, 1, 0); PG8_SCHED; PG8_LDA(At, 1, 0); PG8_STAGE(PG8_SA(0, 1), a2 + hstep, voffA);
            PG8_WAIT_L(8); PG8_BAR; PG8_WAIT_L(0); PG8_MMA(0, 0, At, B0); PG8_BAR; PG8_SCHED;
            PG8_LDB(B1, 1, 1); PG8_STAGE(PG8_SB(1, 0), b3, voffB);
            PG8_BAR; PG8_WAIT_L(0); PG8_MMA(0, 1, At, B1); PG8_BAR;
            PG8_LDA(At, 1, 1); PG8_STAGE(PG8_SA(1, 0), a3, voffA);
            PG8_BAR; PG8_WAIT_L(0); PG8_MMA(1, 0, At, B0); PG8_BAR; PG8_SCHED;
            PG8_STAGE(PG8_SB(1, 1), b3 + hstep, voffB);
            PG8_WAIT_V(6); PG8_BAR; PG8_MMA(1, 1, At, B1); PG8_BAR;
            }
        }
        if constexpr (ALIGN_EPI) { if (wr == 0) PG8_BAR; }
        if constexpr (!Epi::AFTER_DRAIN) { E(acc, cur, wr, wc, fr, fq); S.done(cur); }
        if (!has_next) break;
#pragma unroll
        for (int a = 0; a < 2; ++a)
#pragma unroll
            for (int b = 0; b < 2; ++b)
#pragma unroll
                for (int m = 0; m < 4; ++m)
#pragma unroll
                    for (int n = 0; n < 2; ++n) acc[a][b][m][n] = (f32x4){0.f, 0.f, 0.f, 0.f};
        cur = nxt; cA = nA; cB = nB; ++ui;
        if constexpr (ALIGN_EPI) { if (wr == 1) PG8_BAR; }
    }
    PG8_WAIT_V(0);
    if constexpr (!ALIGN_EPI) { if (wr == 0) PG8_BAR; }
    PG8_BAR;
#undef PG8_SA
#undef PG8_SB
#undef PG8_STAGE
#undef PG8_LDA
#undef PG8_LDB
#undef PG8_MMA
#undef PG8_WAIT_V
#undef PG8_WAIT_L
#undef PG8_BAR
#undef PG8_SCHED
}
}

DI void norm_tail(const pg8::SplitOrder& S, const bf16_t* x16, bf16_t* HN, const float* mod, const float* g, unsigned char* ctl, LAS unsigned char* lds, int tid) {
    const float* sumsq = (const float*)(ctl + CTL_SSQ_A); unsigned* cnt = (unsigned*)(ctl + CTL_CNT_A);
    LAS float* rsl = (LAS float*)lds;
    for (int i = 0; ; ++i) {
        pg8::Unit u; if (!S.next(i, u)) break;
        if (u.part >= 0) continue;
        if (tid == 0) { unsigned sp = 0; while (__hip_atomic_load(cnt + 16 * u.pm, __ATOMIC_RELAXED, __HIP_MEMORY_SCOPE_AGENT) < 32u) { __builtin_amdgcn_s_sleep(2); if (++sp > (1u << 20)) break; } }
        __syncthreads();
        if (tid < 256) rsl[tid] = __builtin_amdgcn_rsqf(__hip_atomic_load(sumsq + u.pm * 256 + tid, __ATOMIC_RELAXED, __HIP_MEMORY_SCOPE_AGENT) * (1.0f / DM) + EPS);
        const int c = u.pn * 256 + (tid & 31) * 8, r0 = tid >> 5;
        const float* md = mod + (size_t)((u.pm * 256) >> 14) * NMOD;
        const f32x4 A0 = *(const f32x4*)(g + c) * (*(const f32x4*)(md + 7 * DM + c) + 1.0f), A1 = *(const f32x4*)(g + c + 4) * (*(const f32x4*)(md + 7 * DM + c + 4) + 1.0f);
        const f32x4 B0 = *(const f32x4*)(md + 6 * DM + c), B1 = *(const f32x4*)(md + 6 * DM + c + 4);
        __syncthreads();
#pragma unroll 4
        for (int k = 0; k < 16; ++k) {
            const int rl = r0 + 16 * k; const size_t eo = (size_t)(u.pm * 256 + rl) * DM + c; const float rs = rsl[rl];
            const u32x4 p = *(const u32x4*)(x16 + eo);
            const f32x4 x0 = {bflo(p.x), bfhi(p.x), bflo(p.y), bfhi(p.y)}, x1 = {bflo(p.z), bfhi(p.z), bflo(p.w), bfhi(p.w)};
            const f32x4 h0 = (x0 * rs) * A0 + B0, h1 = (x1 * rs) * A1 + B1;
            u32x4 v; v.x = cvt_pk_bf16(h0[0], h0[1]); v.y = cvt_pk_bf16(h0[2], h0[3]); v.z = cvt_pk_bf16(h1[0], h1[1]); v.w = cvt_pk_bf16(h1[2], h1[3]);
            *(u32x4*)(HN + eo) = v;
        }
        __syncthreads();
    }
}

struct KArgs {
    const float *x_prompt, *x_sample, *st_C, *st_n, *st_m, *st_conv, *cache_k, *cache_v, *c_prompt, *c_sample, *w_ada, *b_ada, *g_norm,
                *w_up1, *w_dn1, *w_up2, *w_dn2, *w_in, *conv_w, *conv_b, *b_gates, *g_mlstm, *rel_tab, *w_out, *g_final;
    float* out; unsigned char* ws;
    int ph_lo, ph_hi;
};

DI void transpose_item(const float* W, int ldw, int src_col0, int k0, bf16_t* WT, int K, int dest_row0, LAS float* scr, int lane) {
#pragma unroll 8
    for (int i = 0; i < 32; ++i) { const int kk = 2 * i + (lane >> 5); scr[kk * 33 + (lane & 31)] = W[(size_t)(k0 + kk) * ldw + src_col0 + (lane & 31)]; }
    asm volatile("s_waitcnt lgkmcnt(0)" ::: "memory");
    const int c = lane & 7;
#pragma unroll
    for (int j = 0; j < 4; ++j) { const int n = (lane >> 3) + 8 * j; const LAS float* s = scr + (8 * c) * 33 + n;
        u32x4 o; o.x = cvt_pk_bf16(s[0 * 33], s[1 * 33]); o.y = cvt_pk_bf16(s[2 * 33], s[3 * 33]); o.z = cvt_pk_bf16(s[4 * 33], s[5 * 33]); o.w = cvt_pk_bf16(s[6 * 33], s[7 * 33]);
        *(u32x4*)(WT + (size_t)(dest_row0 + n) * K + k0 + 8 * c) = o; }
    asm volatile("s_waitcnt lgkmcnt(0)" ::: "memory");
}
DI void up_item(const float* W, bf16_t* WT, int it, LAS float* scr, int lane) {
    const int kb = it / 176, nb = it % 176, n0 = 32 * nb; const bool isu = n0 >= DFF; const int hid = isu ? n0 - DFF : n0;
    transpose_item(W, NUP, n0, 64 * kb, WT, DM, (hid >> 7) * 256 + (isu ? 128 : 0) + (hid & 127), scr, lane);
}
DI void convert_group(const KArgs& a, int grp, int widx, int nw, LAS unsigned char* lds, int wave, int lane) {
    LAS float* scr = (LAS float*)(lds + wave * 8448);
    constexpr int I_UP = 16 * 176, I_DN = 44 * 32, I_IN = 16 * 112, I_OUT = 16 * 32;
    if (grp == 0) {
        for (int r = widx; r < I_UP; r += nw) up_item(a.w_up1, (bf16_t*)(a.ws + WS_WUP1), r, scr, lane);
    } else if (grp == 1) {
        for (int r = widx; r < I_DN + I_IN + I_OUT; r += nw) {
            if (r < I_DN) transpose_item(a.w_dn1, DM, 32 * (r % 32), 64 * (r / 32), (bf16_t*)(a.ws + WS_WDN1), DFF, 32 * (r % 32), scr, lane);
            else if (r < I_DN + I_IN) { const int q = r - I_DN, n0 = 32 * (q % 112); transpose_item(a.w_in, DIN, n0 + (n0 >= 2048 ? 8 : 0), 64 * (q / 112), (bf16_t*)(a.ws + WS_WIN), DM, n0, scr, lane); }
            else { const int q = r - I_DN - I_IN; transpose_item(a.w_out, DM, 32 * (q % 32), 64 * (q / 32), (bf16_t*)(a.ws + WS_WOUT), DM, 32 * (q % 32), scr, lane); }
        }
    } else {
        const float* wu = grp == 0 ? a.w_up1 : a.w_up2; const float* wd = grp == 0 ? a.w_dn1 : a.w_dn2;
        bf16_t* du = (bf16_t*)(a.ws + (grp == 0 ? WS_WUP1 : WS_WUP2)); bf16_t* dd = (bf16_t*)(a.ws + (grp == 0 ? WS_WDN1 : WS_WDN2));
        for (int r = widx; r < I_UP + I_DN; r += nw) {
            if (r < I_UP) up_item(wu, du, r, scr, lane);
            else { const int q = r - I_UP; transpose_item(wd, DM, 32 * (q % 32), 64 * (q / 32), dd, DFF, 32 * (q % 32), scr, lane); }
        }
    }
}
DI void kvc_convert(const KArgs& a, int T, int NT) {
    bf16_t* KVC = (bf16_t*)(a.ws + WS_CST);
    for (int pc = T; pc < 32 * 512 * 128; pc += NT) {
        const int row = pc >> 7, q = pc & 127;
        const f32x4* src = (const f32x4*)((q < 64 ? a.cache_k : a.cache_v) + (size_t)row * 512 + (q & 63) * 8);
        const f32x4 v0 = src[0], v1 = src[1];
        u32x4 w; w.x = cvt_pk_bf16(v0[0], v0[1]); w.y = cvt_pk_bf16(v0[2], v0[3]); w.z = cvt_pk_bf16(v1[0], v1[1]); w.w = cvt_pk_bf16(v1[2], v1[3]);
        *(u32x4*)(KVC + (size_t)row * 1024 + q * 8) = w;
    }
}
DI void phase_prologue(const KArgs& a, LAS unsigned char* lds, int tid, int wave, int lane) {
    float* mod = (float*)(a.ws + WS_MOD);
    for (int cgi = blockIdx.x; cgi < NMOD / 64; cgi += gridDim.x) {
        LAS float* cs = (LAS float*)lds;
        for (int i = tid; i < 34 * 1024; i += 512) { const int r = i >> 10, k = i & 1023; const float c = r < 2 ? a.c_prompt[r * 1024 + k] : a.c_sample[(r - 2) * 1024 + k]; cs[i] = siluf_(c); }
        __syncthreads();
        float acc[34];
#pragma unroll
        for (int r = 0; r < 34; ++r) acc[r] = 0.f;
        const int col = cgi * 64 + lane;
        const float* wp = a.w_ada + (size_t)(wave * 128) * NMOD + col;
#define ADA_LD(dst, k4) do { const int kc_ = (k4) < 128 ? (k4) : 124; _Pragma("unroll") for (int i = 0; i < 4; ++i) dst[i] = wp[(size_t)(kc_ + i) * NMOD]; } while (0)
        float wa[4], wb[4], wc[4], wd[4];
        ADA_LD(wa, 0); ADA_LD(wb, 4); ADA_LD(wc, 8); ADA_LD(wd, 12);
        for (int kk = 0; kk < 128; kk += 4) {
            const int k = wave * 128 + kk;
            float w[4];
#pragma unroll
            for (int i = 0; i < 4; ++i) { w[i] = wa[i]; wa[i] = wb[i]; wb[i] = wc[i]; wc[i] = wd[i]; }
            ADA_LD(wd, kk + 16);
#pragma unroll
            for (int r = 0; r < 34; ++r) { const f32x4 c4 = *(const LAS f32x4*)(cs + r * 1024 + k); acc[r] += c4[0] * w[0] + c4[1] * w[1] + c4[2] * w[2] + c4[3] * w[3]; }
        }
#undef ADA_LD
        __syncthreads();
        LAS float* part = (LAS float*)lds;
#pragma unroll
        for (int r = 0; r < 34; ++r) part[(wave * 34 + r) * 64 + lane] = acc[r];
        __syncthreads();
        for (int o = tid; o < 34 * 64; o += 512) { const int r = o >> 6, l = o & 63; float s = a.b_ada[cgi * 64 + l];
#pragma unroll
            for (int w = 0; w < 8; ++w) s += part[(w * 34 + r) * 64 + l];
            mod[(size_t)r * NMOD + cgi * 64 + l] = s; }
        __syncthreads();
    }
    {
        bf16_t* PREVB = (bf16_t*)(a.ws + WS_PREVB);
        const int T = blockIdx.x * 512 + tid, NT = gridDim.x * 512;
        for (int i = T; i < 34 * 3 * 512; i += NT) {
            const int e = i * 2;
            unsigned w = 0u;
            if (e >= 2 * 3 * 1024) { const float* p = a.st_conv + (e - 2 * 3 * 1024); w = cvt_pk_bf16(p[0], p[1]); }
            *(unsigned*)(PREVB + e) = w;
        }
    }
    convert_group(a, 0, blockIdx.x * 8 + wave, gridDim.x * 8, lds, wave, lane);
}

template <bool GATES, int NSPLIT, bool P16>
DI void phase_norm(const KArgs& a, const float* xp, const bf16_t* xp16, const float* xs, float* xsw, const float* g, int shift_off, int scale_off, int pgate_off, float pcoef, int row_begin, LAS unsigned char* lds, int tid, int wave, int lane) {
    const float* mod = (const float*)(a.ws + WS_MOD);
    bf16_t* HN = (bf16_t*)(a.ws + WS_HN);
    float* gates = (float*)(a.ws + WS_GATES);
    f32x4 wgr[8][4];
    if (GATES) {
#pragma unroll
        for (int j = 0; j < 4; ++j)
#pragma unroll
            for (int i = 0; i < 4; ++i) {
                const f32x4* p = (const f32x4*)(a.w_in + (size_t)(4 * lane + 256 * j + i) * DIN + 2048);
                const f32x4 lo = p[0], hi = p[1];
                wgr[0][j][i] = lo[0]; wgr[1][j][i] = lo[1]; wgr[2][j][i] = lo[2]; wgr[3][j][i] = lo[3]; wgr[4][j][i] = hi[0]; wgr[5][j][i] = hi[1]; wgr[6][j][i] = hi[2]; wgr[7][j][i] = hi[3];
            }
    }
    const int gw = blockIdx.x * 8 + wave, NGW = gridDim.x * 8;
    for (int row = row_begin + gw; row < M; row += NGW) {
        f32x4 v[4]; float ss = 0.f;
        if (P16 && row < MP) {
            const u32x2* xr = (const u32x2*)(xp16 + (size_t)row * DM) + lane;
#pragma unroll
            for (int j = 0; j < 4; ++j) { const u32x2 w = xr[64 * j]; v[j] = (f32x4){bflo(w.x), bfhi(w.x), bflo(w.y), bfhi(w.y)}; }
        } else {
            const f32x4* xr = (const f32x4*)(row < MP ? xp + (size_t)row * DM : xs + (size_t)(row - MP) * DM) + lane;
#pragma unroll
            for (int j = 0; j < 4; ++j) v[j] = xr[64 * j];
        }
        const float* md = mod + (size_t)modrow(row) * NMOD;
        if (NSPLIT > 0 && row >= MP) {
            const float* part = (const float*)(a.ws + WS_UT) + (size_t)(row - MP) * DM;
#pragma unroll
            for (int j = 0; j < 4; ++j) {
                const int col = 4 * lane + 256 * j;
                f32x4 sum = *(const f32x4*)(part + col);
#pragma unroll
                for (int sp = 1; sp < NSPLIT; ++sp) sum += *(const f32x4*)(part + (size_t)sp * MS * DM + col);
                v[j] += (*(const f32x4*)(md + pgate_off + col) * pcoef) * sum;
                *(f32x4*)(xsw + (size_t)(row - MP) * DM + col) = v[j];
            }
        }
#pragma unroll
        for (int j = 0; j < 4; ++j) ss += (v[j][0] * v[j][0] + v[j][1] * v[j][1]) + (v[j][2] * v[j][2] + v[j][3] * v[j][3]);
        const float rstd = 1.0f / sqrtf(wave_sum(ss) * (1.0f / DM) + EPS);
        float gp[8];
#pragma unroll
        for (int c = 0; c < 8; ++c) gp[c] = 0.f;
#pragma unroll
        for (int j = 0; j < 4; ++j) {
            const int col = 4 * lane + 256 * j;
            const f32x4 g4 = *(const f32x4*)(g + col), sc = *(const f32x4*)(md + scale_off + col), sh = *(const f32x4*)(md + shift_off + col);
            const f32x4 h = (v[j] * rstd * g4) * (sc + 1.0f) + sh;
            u32x2 w; w.x = cvt_pk_bf16(h[0], h[1]); w.y = cvt_pk_bf16(h[2], h[3]);
            *(u32x2*)(HN + (size_t)row * DM + col) = w;
            if (GATES) {
#pragma unroll
                for (int c = 0; c < 8; ++c) { const f32x4 w4 = wgr[c][j]; gp[c] += (h[0] * w4[0] + h[1] * w4[1]) + (h[2] * w4[2] + h[3] * w4[3]); }
            }
        }
        if (GATES) {
            const bool b5 = (lane & 32) != 0, b4 = (lane & 16) != 0, b3 = (lane & 8) != 0;
            float k4[4], k2[2], k1;
#pragma unroll
            for (int i = 0; i < 4; ++i) { const float snd = b5 ? gp[i] : gp[i + 4]; k4[i] = (b5 ? gp[i + 4] : gp[i]) + __shfl_xor(snd, 32); }
#pragma unroll
            for (int i = 0; i < 2; ++i) { const float snd = b4 ? k4[i] : k4[i + 2]; k2[i] = (b4 ? k4[i + 2] : k4[i]) + __shfl_xor(snd, 16); }
            { const float snd = b3 ? k2[0] : k2[1]; k1 = (b3 ? k2[1] : k2[0]) + __shfl_xor(snd, 8); }
            k1 += __shfl_xor(k1, 4); k1 += __shfl_xor(k1, 2); k1 += __shfl_xor(k1, 1);
            const int c = (b5 ? 4 : 0) + (b4 ? 2 : 0) + (b3 ? 1 : 0);
            if ((lane & 7) == 0) gates[(size_t)row * 8 + c] = k1 + a.b_gates[c];
        }
    }
}
DI void phase_final_norm(const KArgs& a, const bf16_t* x16, const float* xs, int row_begin, int wave, int lane) {
    const int gw = blockIdx.x * 8 + wave, NGW = gridDim.x * 8;
    const float* mod = (const float*)(a.ws + WS_MOD);
    for (int row = row_begin + gw; row < M; row += NGW) {
        f32x4 v[4]; float ss = 0.f;
        if (row < MP) {
            const u32x2* xr = (const u32x2*)(x16 + (size_t)row * DM) + lane;
#pragma unroll
            for (int j = 0; j < 4; ++j) { const u32x2 w = xr[64 * j]; v[j] = (f32x4){bflo(w.x), bfhi(w.x), bflo(w.y), bfhi(w.y)}; }
        } else {
            const float* part = (const float*)(a.ws + WS_UT) + (size_t)(row - MP) * DM;
            const float* md = mod + (size_t)modrow(row) * NMOD + 8 * DM;
#pragma unroll
            for (int j = 0; j < 4; ++j) {
                const int col = 4 * lane + 256 * j;
                f32x4 sum = *(const f32x4*)(part + col);
#pragma unroll
                for (int sp = 1; sp < 4; ++sp) sum += *(const f32x4*)(part + (size_t)sp * MS * DM + col);
                v[j] = *(const f32x4*)(xs + (size_t)(row - MP) * DM + col) + (*(const f32x4*)(md + col) * 0.5f) * sum;
            }
        }
#pragma unroll
        for (int j = 0; j < 4; ++j) ss += (v[j][0] * v[j][0] + v[j][1] * v[j][1]) + (v[j][2] * v[j][2] + v[j][3] * v[j][3]);
        const float rstd = 1.0f / sqrtf(wave_sum(ss) * (1.0f / DM) + EPS);
        f32x4* yr = (f32x4*)(a.out + (size_t)row * DM) + lane;
#pragma unroll
        for (int j = 0; j < 4; ++j) { const f32x4 g4 = *(const f32x4*)(a.g_final + 4 * lane + 256 * j); yr[64 * j] = v[j] * rstd * g4; }
    }
}

constexpr int TP = 72;
DI void conv_load(const KArgs& a, const bf16_t* PROJ, int gc, int s0, int cch, unsigned (&u)[11]) {
    const int row0 = gc * 64;
    const bool special = gc >= 512 || (gc & 255) == 0;
    const bf16_t* PREVB = (const bf16_t*)(a.ws + WS_PREVB) + (size_t)(gc < 512 ? (gc >> 8) : 2 + (gc - 512)) * 3 * 1024;
#pragma unroll
    for (int r = 0; r < 11; ++r) {
        const int tp = s0 - 3 + r;
        const bf16_t* p = (tp < 0 && special) ? PREVB + (3 + tp) * 1024 + cch : PROJ + (size_t)(row0 + tp) * NPROJ + cch;
        u[r] = *(const unsigned*)p;
    }
}
typedef float f32x2v __attribute__((ext_vector_type(2)));
struct ConvW { f32x2v w[4]; f32x2v b; };
DI void convw_load(const KArgs& a, int cch, ConvW& W) {
#pragma unroll
    for (int j = 0; j < 4; ++j) W.w[j] = *(const f32x2v*)(a.conv_w + j * 1024 + cch);
    W.b = *(const f32x2v*)(a.conv_b + cch);
}
DI void conv_math(const ConvW& W, const unsigned (&u)[11], float (&o0)[8], float (&o1)[8]) {
#pragma unroll
    for (int j = 0; j < 8; ++j) {
        float x0 = W.b[0], x1 = W.b[1];
#pragma unroll
        for (int tap = 0; tap < 4; ++tap) { x0 += W.w[tap][0] * bflo(u[j + tap]); x1 += W.w[tap][1] * bfhi(u[j + tap]); }
        o0[j] = siluf_(x0); o1[j] = siluf_(x1);
    }
}
DI u32x4 pack8f(const float (&v)[8]) { u32x4 w; w.x = cvt_pk_bf16(v[0], v[1]); w.y = cvt_pk_bf16(v[2], v[3]); w.z = cvt_pk_bf16(v[4], v[5]); w.w = cvt_pk_bf16(v[6], v[7]); return w; }
DI void store_vT(const unsigned (&v)[8], int s0, LAS bf16_t* VT, int ch, int sw) {
    u32x4 lo, hi;
    lo.x = (v[0] & 0xffffu) | (v[1] << 16); lo.y = (v[2] & 0xffffu) | (v[3] << 16); lo.z = (v[4] & 0xffffu) | (v[5] << 16); lo.w = (v[6] & 0xffffu) | (v[7] << 16);
    hi.x = (v[0] >> 16) | (v[1] & 0xffff0000u); hi.y = (v[2] >> 16) | (v[3] & 0xffff0000u); hi.z = (v[4] >> 16) | (v[5] & 0xffff0000u); hi.w = (v[6] >> 16) | (v[7] & 0xffff0000u);
    *(LAS u32x4*)(VT + ch * TP + (s0 ^ sw)) = lo; *(LAS u32x4*)(VT + (ch + 1) * TP + (s0 ^ sw)) = hi;
}
DI float gate_cumsum(float fg, int lane) {
    float lf = fminf(fg, 0.f) - 0.6931471805599453f * __builtin_amdgcn_logf(1.0f + fexp(-fabsf(fg)));
#pragma unroll
    for (int o = 1; o < 64; o <<= 1) { const float t = __shfl_up(lf, o); if (lane >= o) lf += t; }
    return lf;
}
DI void store16_bf16(LAS bf16_t* p, const float (&o)[16]) {
    u32x4 w0, w1;
    w0.x = cvt_pk_bf16(o[0], o[1]); w0.y = cvt_pk_bf16(o[2], o[3]); w0.z = cvt_pk_bf16(o[4], o[5]); w0.w = cvt_pk_bf16(o[6], o[7]);
    w1.x = cvt_pk_bf16(o[8], o[9]); w1.y = cvt_pk_bf16(o[10], o[11]); w1.z = cvt_pk_bf16(o[12], o[13]); w1.w = cvt_pk_bf16(o[14], o[15]);
    *(LAS u32x4*)p = w0; *(LAS u32x4*)(p + 8) = w1;
}

struct ALoad { unsigned uk[11], v[8]; float fg, ig; };
DI void a_issue(const KArgs& a, int gc, int h, int wave, int lane, ALoad& L) {
    const bf16_t* PROJ = (const bf16_t*)(a.ws + WS_PROJ);
    const float* gates = (const float*)(a.ws + WS_GATES);
    const int row0 = gc * 64, s0 = 8 * wave, ch = 2 * lane;
    conv_load(a, PROJ, gc, s0, PK + h * 128 + ch, L.uk);
#pragma unroll
    for (int j = 0; j < 8; ++j) L.v[j] = *(const unsigned*)(PROJ + (size_t)(row0 + s0 + j) * NPROJ + PV + h * 128 + ch);
    L.fg = gates[(size_t)(row0 + lane) * 8 + 4 + h]; L.ig = gates[(size_t)(row0 + lane) * 8 + h];
}
DI void mlstmA_loop(const KArgs& a, LAS unsigned char* lds, int jbeg, int jend, int tid, int wave, int lane) {
    float* chk = (float*)(a.ws + WS_CHK);
    bf16_t* UT = (bf16_t*)(a.ws + WS_UT);
    LAS bf16_t* KgT = (LAS bf16_t*)lds;
    LAS bf16_t* VT = (LAS bf16_t*)(lds + 128 * TP * 2);
    const int fr = lane & 15, g = lane >> 4;
    int j = jbeg;
    if (j >= jend) return;
#define A_GC(jx) ((((jx) % NGC) * 33) % NGC)
    ALoad L; a_issue(a, A_GC(j), j / NGC, wave, lane, L);
    ConvW Wk; int hw = j / NGC; convw_load(a, PK + hw * 128 + 2 * lane, Wk);
    for (; j < jend; ++j) {
        const int gc = A_GC(j), h = j / NGC, idx = gc * 4 + h;
        if (h != hw) { hw = h; convw_load(a, PK + hw * 128 + 2 * lane, Wk); }
        const float b = gate_cumsum(L.fg, lane);
        const float bend = __shfl(b, 63);
        const float logg = bend - b + L.ig;
        const float mloc = wave_max(logg);
        const float gv = fexp(logg - mloc);
        if (tid == 0) { chk[idx] = bend; chk[NGC * 4 + idx] = mloc; }
        {
            const int s0 = 8 * wave, ch = 2 * lane, sw = 8 * (ch >> 4);
            float k0[8], k1[8]; conv_math(Wk, L.uk, k0, k1);
#pragma unroll
            for (int j = 0; j < 8; ++j) { const float gs = __shfl(gv, s0 + j) * 0.08838834764831845f; k0[j] *= gs; k1[j] *= gs; }
            *(LAS u32x4*)(KgT + ch * TP + (s0 ^ sw)) = pack8f(k0); *(LAS u32x4*)(KgT + (ch + 1) * TP + (s0 ^ sw)) = pack8f(k1);
            store_vT(L.v, s0, VT, ch, sw);
        }
        __syncthreads();
        { const int jn = j + 1 < jend ? j + 1 : j; a_issue(a, A_GC(jn), jn / NGC, wave, lane, L); }
        bf16x8 aF[2];
#pragma unroll
        for (int ks = 0; ks < 2; ++ks) aF[ks] = *(const LAS bf16x8*)(KgT + (16 * wave + fr) * TP + ((32 * ks + 8 * g) ^ (8 * wave)));
        bf16_t* ub = UT + (size_t)idx * 129 * 128 + 16 * wave + 4 * g;
        const bool smp = gc >= 512; const int sh = (gc - 512) * 4 + h, dk0 = 16 * wave + 4 * g;
        float dec = 0.f, scl = 0.f;
        bf16_t* cb = (bf16_t*)(a.ws + WS_CST) + (size_t)idx * 129 * 128 + dk0;
        if (smp) {
            const float m_in = a.st_m[sh], mn = fmaxf(bend + m_in, mloc);
            dec = fexp(bend + m_in - mn); scl = fexp(mloc - mn);
            if (tid == 0) { chk[2 * NGC * 4 + idx] = m_in; a.out[OFF_M_S + sh] = mn; }
        }
#pragma unroll
        for (int jt = 0; jt < 8; ++jt) {
            f32x4 acc = {0.f, 0.f, 0.f, 0.f};
#pragma unroll
            for (int ks = 0; ks < 2; ++ks) { const bf16x8 bF = *(const LAS bf16x8*)(VT + (16 * jt + fr) * TP + ((32 * ks + 8 * g) ^ (8 * jt))); acc = MFMA16(aF[ks], bF, acc); }
            if (!smp) {
                u32x2 w; w.x = cvt_pk_bf16(acc[0], acc[1]); w.y = cvt_pk_bf16(acc[2], acc[3]);
                *(u32x2*)(ub + (size_t)(16 * jt + fr) * 128) = w;
            } else {
                const size_t eo = ((size_t)sh * 128 + dk0) * 128 + 16 * jt + fr;
                const float* ci = a.st_C + eo; float* co = a.out + OFF_C_S + eo;
                const float c0 = ci[0], c1 = ci[128], c2 = ci[256], c3 = ci[384];
                co[0] = dec * c0 + scl * acc[0]; co[128] = dec * c1 + scl * acc[1]; co[256] = dec * c2 + scl * acc[2]; co[384] = dec * c3 + scl * acc[3];
                u32x2 w; w.x = cvt_pk_bf16(c0, c1); w.y = cvt_pk_bf16(c2, c3);
                *(u32x2*)(cb + (size_t)(16 * jt + fr) * 128) = w;
            }
        }
        {
            const short one = fr == 0 ? (short)0x3F80 : (short)0;
            const bf16x8 bF = {one, one, one, one, one, one, one, one};
            f32x4 acc = {0.f, 0.f, 0.f, 0.f};
#pragma unroll
            for (int ks = 0; ks < 2; ++ks) acc = MFMA16(aF[ks], bF, acc);
            if (fr == 0) {
                if (!smp) { u32x2 w; w.x = cvt_pk_bf16(acc[0], acc[1]); w.y = cvt_pk_bf16(acc[2], acc[3]); *(u32x2*)(ub + (size_t)128 * 128) = w; }
                else {
                    const f32x4 n4 = *(const f32x4*)(a.st_n + (size_t)sh * 128 + dk0);
                    *(f32x4*)(a.out + OFF_N_S + (size_t)sh * 128 + dk0) = n4 * dec + acc * scl;
                    u32x2 w; w.x = cvt_pk_bf16(n4[0], n4[1]); w.y = cvt_pk_bf16(n4[2], n4[3]); *(u32x2*)(cb + (size_t)128 * 128) = w;
                }
            }
        }
        __syncthreads();
    }
}

DI bf16x8 pack8(const f32x4 lo, const f32x4 hi) {
    u32x4 w; w.x = cvt_pk_bf16(lo[0], lo[1]); w.y = cvt_pk_bf16(lo[2], lo[3]); w.z = cvt_pk_bf16(hi[0], hi[1]); w.w = cvt_pk_bf16(hi[2], hi[3]);
    return __builtin_bit_cast(bf16x8, w);
}
constexpr int VP32 = 40;
constexpr int ATT_WAVE_LDS = 64 * 64 * 2 + 64 * VP32 * 2;
DI void attn_item(const KArgs& a, int gc, LAS unsigned char* lds, int wave, int lane) {
    const bf16_t* PROJ = (const bf16_t*)(a.ws + WS_PROJ);
    const bf16_t* KVC = (const bf16_t*)(a.ws + WS_CST);
    bf16_t* MIX = (bf16_t*)(a.ws + WS_HN);
    const int h = wave, fr = lane & 15, g = lane >> 4, row0 = gc * 64;
    const bool is_s = gc >= 512; const int sidx = gc - 512, c = gc & 255;
    LAS unsigned char* Qs = lds + wave * ATT_WAVE_LDS;
    LAS bf16_t* VT = (LAS bf16_t*)(lds + wave * ATT_WAVE_LDS + 8192);
    const LAS float* tab = (const LAS float*)(lds + TAB_OFF) + h * 256;
#pragma unroll
    for (int i8 = 0; i8 < 8; ++i8) {
        const int t = (lane >> 3) + 8 * i8, cq = lane & 7;
        const u32x4 w = *(const u32x4*)(PROJ + (size_t)(row0 + t) * NPROJ + PAQ + 64 * h + 8 * cq);
        *(LAS u32x4*)(Qs + t * 128 + ((cq ^ (t & 7)) << 4)) = w;
    }
    float mrun[4], lrun[4]; f32x4 oacc[4][4];
#pragma unroll
    for (int tt = 0; tt < 4; ++tt) { mrun[tt] = -INFINITY; lrun[tt] = 0.f;
#pragma unroll
        for (int dt = 0; dt < 4; ++dt) oacc[dt][tt] = (f32x4){0.f, 0.f, 0.f, 0.f}; }
    const int kt0 = is_s ? 0 : (c >= 8 ? 0 : 8 - c);
#define ATT_SRC(j2_, kp_, vp_, pitch_) do { const int kt_ = (j2_) >> 1, hf_ = (j2_) & 1; if (is_s && kt_ < 8) { kp_ = KVC + (size_t)(sidx * 512 + 64 * kt_ + 32 * hf_) * 1024 + 64 * h; vp_ = kp_ + 512; pitch_ = 1024; } \
        else { const size_t kr_ = (size_t)(row0 - (8 - kt_) * 64 + 32 * hf_); kp_ = PROJ + kr_ * NPROJ + PAK + 64 * h; vp_ = PROJ + kr_ * NPROJ + PAV + 64 * h; pitch_ = NPROJ; } } while (0)
#define ATT_LOAD(KF, VR, kp_, vp_, pitch_) do { const unsigned koff_ = (unsigned)(fr * (pitch_) + 8 * g) * 2u, voff_ = (unsigned)((lane >> 3) * (pitch_) + 8 * (lane & 7)) * 2u; \
        _Pragma("unroll") for (int it = 0; it < 2; ++it) _Pragma("unroll") for (int ks = 0; ks < 2; ++ks) KF[it][ks] = *(const bf16x8*)((const char*)(kp_ + (size_t)(16 * it) * (pitch_) + 32 * ks) + koff_); \
        _Pragma("unroll") for (int jj = 0; jj < 4; ++jj) VR[jj] = *(const u32x4*)((const char*)(vp_ + (size_t)(8 * jj) * (pitch_)) + voff_); } while (0)
    bf16x8 kf[2][2]; u32x4 vr[4];
    { const bf16_t* kp; const bf16_t* vp; int pitch; ATT_SRC(2 * kt0, kp, vp, pitch); ATT_LOAD(kf, vr, kp, vp, pitch); }
    const float bias_far = tab[191];
    for (int j2 = 2 * kt0; j2 < 18; ++j2) {
#pragma unroll
        for (int jj = 0; jj < 4; ++jj) {
            const int key = (lane >> 3) + 8 * jj, p = lane & 7, ksw = key ^ (8 * (p & 3));
            const unsigned ww[4] = {vr[jj].x, vr[jj].y, vr[jj].z, vr[jj].w};
#pragma unroll
            for (int e = 0; e < 4; ++e) { VT[(8 * p + 2 * e) * VP32 + ksw] = (bf16_t)(ww[e] & 0xffffu); VT[(8 * p + 2 * e + 1) * VP32 + ksw] = (bf16_t)(ww[e] >> 16); }
        }
        bf16x8 kn[2][2];
        { const int jn = j2 < 17 ? j2 + 1 : j2; const bf16_t* kp; const bf16_t* vp; int pitch; ATT_SRC(jn, kp, vp, pitch); ATT_LOAD(kn, vr, kp, vp, pitch); }
        const int kt = j2 >> 1;
        const int relb = 64 * (8 - kt) - 32 * (j2 & 1);
        const LAS float* tb = tab + (fr - 4 * g + relb + 63 - 64);
        bf16x8 vA[4];
#pragma unroll
        for (int dt = 0; dt < 4; ++dt) {
            const int sw = 8 * ((2 * dt + (fr >> 3)) & 3);
            const LAS bf16_t* vrow = VT + (16 * dt + fr) * VP32;
            const s16x4 lo = *(const LAS s16x4*)(vrow + ((4 * g) ^ sw)), hi = *(const LAS s16x4*)(vrow + ((16 + 4 * g) ^ sw));
            vA[dt] = __builtin_shufflevector(lo, hi, 0, 1, 2, 3, 4, 5, 6, 7);
        }
        f32x4 sacc[4][2];
#pragma unroll
        for (int tt = 0; tt < 4; ++tt) {
            const int t = 16 * tt + fr;
            bf16x8 qB[2];
#pragma unroll
            for (int ks = 0; ks < 2; ++ks) qB[ks] = *(const LAS bf16x8*)(Qs + t * 128 + (((4 * ks + g) ^ (t & 7)) << 4));
#pragma unroll
            for (int it = 0; it < 2; ++it) { sacc[tt][it] = (f32x4){0.f, 0.f, 0.f, 0.f};
#pragma unroll
                for (int ks = 0; ks < 2; ++ks) sacc[tt][it] = MFMA16(kf[it][ks], qB[ks], sacc[tt][it]); }
        }
        if (kt <= 5) {
#pragma unroll
            for (int tt = 0; tt < 4; ++tt)
#pragma unroll
                for (int it = 0; it < 2; ++it)
#pragma unroll
                    for (int r = 0; r < 4; ++r) sacc[tt][it][r] = __builtin_fmaf(sacc[tt][it][r], 0.125f * LOG2E, bias_far);
        } else {
#pragma unroll
            for (int tt = 0; tt < 4; ++tt)
#pragma unroll
                for (int it = 0; it < 2; ++it)
#pragma unroll
                    for (int r = 0; r < 4; ++r) sacc[tt][it][r] = __builtin_fmaf(sacc[tt][it][r], 0.125f * LOG2E, tb[16 * (tt - it) - r + 64]);
        }
        float tmax[4]; bool need = false;
#pragma unroll
        for (int tt = 0; tt < 4; ++tt) {
            float m = __builtin_fmaxf(__builtin_fmaxf(sacc[tt][0][0], sacc[tt][0][1]), sacc[tt][0][2]);
            m = __builtin_fmaxf(__builtin_fmaxf(m, sacc[tt][0][3]), sacc[tt][1][0]);
            m = __builtin_fmaxf(__builtin_fmaxf(m, sacc[tt][1][1]), sacc[tt][1][2]);
            tmax[tt] = __builtin_fmaxf(m, sacc[tt][1][3]);
            need = need || (tmax[tt] > mrun[tt] + 8.0f);
        }
        if (__any(need)) {
#pragma unroll
            for (int tt = 0; tt < 4; ++tt) {
                float m = tmax[tt]; m = __builtin_fmaxf(m, __shfl_xor(m, 16)); m = __builtin_fmaxf(m, __shfl_xor(m, 32));
                const float mnew = __builtin_fmaxf(mrun[tt], m);
                const float alpha = fexp2(mrun[tt] - mnew); lrun[tt] *= alpha; mrun[tt] = mnew;
#pragma unroll
                for (int dt = 0; dt < 4; ++dt) oacc[dt][tt] = oacc[dt][tt] * alpha;
            }
        }
#pragma unroll
        for (int tt = 0; tt < 4; ++tt) {
            const float mref = mrun[tt];
            float lsum = 0.f;
#pragma unroll
            for (int it = 0; it < 2; ++it)
#pragma unroll
                for (int r = 0; r < 4; ++r) { const float p = fexp2(sacc[tt][it][r] - mref); sacc[tt][it][r] = p; lsum += p; }
            lrun[tt] += lsum;
            const bf16x8 pB = pack8(sacc[tt][0], sacc[tt][1]);
#pragma unroll
            for (int dt = 0; dt < 4; ++dt) oacc[dt][tt] = MFMA16(vA[dt], pB, oacc[dt][tt]);
        }
#pragma unroll
        for (int it = 0; it < 2; ++it)
#pragma unroll
            for (int ks = 0; ks < 2; ++ks) kf[it][ks] = kn[it][ks];
    }
#undef ATT_SRC
#undef ATT_LOAD
#pragma unroll
    for (int tt = 0; tt < 4; ++tt) {
        float l = lrun[tt]; l += __shfl_xor(l, 16); l += __shfl_xor(l, 32);
        const float inv = 1.0f / l;
#pragma unroll
        for (int dt = 0; dt < 4; ++dt) {
            const f32x4 o = oacc[dt][tt] * inv;
            u32x2 w; w.x = cvt_pk_bf16(o[0], o[1]); w.y = cvt_pk_bf16(o[2], o[3]);
            *(u32x2*)(MIX + (size_t)(row0 + 16 * tt + fr) * DM + 512 + 64 * h + 16 * dt + 4 * g) = w;
        }
    }
}
#ifndef ATT_N7
#define ATT_N7 191
#endif
DI void phase_mixA(const KArgs& a, LAS unsigned char* lds, int tid, int wave, int lane) {
    LAS float* tab = (LAS float*)(lds + TAB_OFF);
    for (int i = tid; i < 8 * 256; i += 512) { const int e = i & 255; tab[i] = a.rel_tab[(i >> 8) * 192 + (e > 191 ? 191 : e)] * LOG2E; }
    __syncthreads();
    for (int it = ATT_N7 + blockIdx.x; it < NGC; it += gridDim.x) attn_item(a, it, lds, wave, lane);
    __syncthreads();
    int jbeg, jend; const int b = (int)blockIdx.x, Gd = (int)gridDim.x;
    if (Gd == 256 && ATT_N7 == 191) {
        const int n2 = (NGC - ATT_N7) - 256;
        constexpr int NLO = 4, NHI = 11; const int extra = NGC * 4 - (n2 * NLO + (256 - n2) * NHI);
        if (b < n2) { jbeg = NLO * b; jend = jbeg + NLO; }
        else { const int q = b - n2; jbeg = n2 * NLO + q * NHI + (q < extra ? q : extra); jend = jbeg + NHI + (q < extra ? 1 : 0); }
    } else { const int per = (NGC * 4 + Gd - 1) / Gd; jbeg = b * per; jend = jbeg + per < NGC * 4 ? jbeg + per : NGC * 4; }
    mlstmA_loop(a, lds, jbeg, jend, tid, wave, lane);
}

DI void phase_scan(const KArgs& a, int tid) {
    const bf16_t* UT = (const bf16_t*)(a.ws + WS_UT);
    bf16_t* CST = (bf16_t*)(a.ws + WS_CST);
    float* chk = (float*)(a.ws + WS_CHK);
    const float* bend = chk; const float* mloc = chk + NGC * 4; float* mst = chk + 2 * NGC * 4;
    constexpr int E4 = 129 * 128 / 4, NPI = 8 * E4;
    const int T = blockIdx.x * 512 + tid, NT = gridDim.x * 512;
    for (int it = T; it < NPI; it += NT) {
        const int bh = it / E4, e4 = it % E4, bb = bh >> 2, h = bh & 3;
        float c0 = 0.f, c1 = 0.f, c2 = 0.f, c3 = 0.f, m = 0.f;
        const size_t estride = (size_t)4 * 129 * 128;
        const size_t e0 = ((size_t)(bb * 256) * 4 + h) * 129 * 128 + (size_t)e4 * 4;
        const int i0 = bb * 256 * 4 + h;
        u32x2 ub[8]; float be[8], ml[8];
#pragma unroll
        for (int j = 0; j < 8; ++j) { ub[j] = *(const u32x2*)(UT + e0 + (size_t)j * estride); be[j] = bend[i0 + 4 * j]; ml[j] = mloc[i0 + 4 * j]; }
        for (int grp = 0; grp < 32; ++grp) {
            u32x2 un[8]; float ben[8], mln[8];
            const int cn = (grp + 1 < 32 ? grp + 1 : grp) * 8;
#pragma unroll
            for (int j = 0; j < 8; ++j) { un[j] = *(const u32x2*)(UT + e0 + (size_t)(cn + j) * estride); ben[j] = bend[i0 + 4 * (cn + j)]; mln[j] = mloc[i0 + 4 * (cn + j)]; }
#pragma unroll
            for (int j = 0; j < 8; ++j) {
                const int cc = grp * 8 + j;
                u32x2 w; w.x = cvt_pk_bf16(c0, c1); w.y = cvt_pk_bf16(c2, c3);
                *(u32x2*)(CST + e0 + (size_t)cc * estride) = w;
                if (e4 == 0) mst[i0 + 4 * cc] = m;
                const float mn = fmaxf(be[j] + m, ml[j]);
                const float dec = fexp(be[j] + m - mn), sc = fexp(ml[j] - mn);
                c0 = dec * c0 + sc * bflo(ub[j].x); c1 = dec * c1 + sc * bfhi(ub[j].x); c2 = dec * c2 + sc * bflo(ub[j].y); c3 = dec * c3 + sc * bfhi(ub[j].y);
                m = mn;
            }
#pragma unroll
            for (int j = 0; j < 8; ++j) { ub[j] = un[j]; be[j] = ben[j]; ml[j] = mln[j]; }
        }
        const int e = e4 * 4, dv = e >> 7, dk = e & 127;
        if (dv < 128) { float* o = a.out + OFF_C_P + ((size_t)bh * 128 + dk) * 128 + dv; o[0] = c0; o[128] = c1; o[256] = c2; o[384] = c3; }
        else { float* o = a.out + OFF_N_P + (size_t)bh * 128 + dk; o[0] = c0; o[1] = c1; o[2] = c2; o[3] = c3; }
        if (e4 == 0) a.out[OFF_M_P + bh] = m;
    }
}

constexpr int QP = 136;
constexpr int C_QS = 0, C_KS = C_QS + 64 * QP * 2, C_VT = C_KS + 64 * QP * 2, C_CT = C_VT + 144 * TP * 2, C_SS = C_CT + 144 * QP * 2, C_END = C_SS + 512;
static_assert(C_END <= TAB_OFF, "phase C LDS");
struct CLoad { unsigned uq[11], uk[11], v[8]; u32x4 ct[5]; u32x2 mo[4]; float fg, ig, mprev; };
DI void c_issue(const KArgs& a, int gc, int h, int tid, int wave, int lane, CLoad& L) {
    const bf16_t* PROJ = (const bf16_t*)(a.ws + WS_PROJ);
    const float* gates = (const float*)(a.ws + WS_GATES);
    const float* mst = (const float*)(a.ws + WS_CHK) + 2 * NGC * 4;
    const bf16_t* CST = (const bf16_t*)(a.ws + WS_CST);
    const int row0 = gc * 64, idx = gc * 4 + h, s0 = 8 * wave, ch = 2 * lane, fr = lane & 15, g = lane >> 4;
    conv_load(a, PROJ, gc, s0, PQ + h * 128 + ch, L.uq);
    conv_load(a, PROJ, gc, s0, PK + h * 128 + ch, L.uk);
#pragma unroll
    for (int j = 0; j < 8; ++j) L.v[j] = *(const unsigned*)(PROJ + (size_t)(row0 + s0 + j) * NPROJ + PV + h * 128 + ch);
#pragma unroll
    for (int i = 0; i < 5; ++i) { const int p8 = tid + 512 * i; int dv = p8 >> 4; dv = dv > 128 ? 128 : dv; L.ct[i] = *(const u32x4*)(CST + ((size_t)idx * 129 + dv) * 128 + (p8 & 15) * 8); }
    const int t = 16 * (wave & 3) + fr, dh = wave >> 2;
#pragma unroll
    for (int q = 0; q < 4; ++q) L.mo[q] = *(const u32x2*)(PROJ + (size_t)(row0 + t) * NPROJ + PO + h * 128 + 16 * (4 * dh + q) + 4 * g);
    L.fg = gates[(size_t)(row0 + lane) * 8 + 4 + h]; L.ig = gates[(size_t)(row0 + lane) * 8 + h]; L.mprev = mst[idx];
}
DI void phase_mixC(const KArgs& a, LAS unsigned char* lds, int tid, int wave, int lane) {
    bf16_t* MIX = (bf16_t*)(a.ws + WS_HN);
    LAS bf16_t* Qs = (LAS bf16_t*)(lds + C_QS); LAS bf16_t* Ks = (LAS bf16_t*)(lds + C_KS); LAS bf16_t* VT = (LAS bf16_t*)(lds + C_VT); LAS bf16_t* CT = (LAS bf16_t*)(lds + C_CT);
    LAS float* SS = (LAS float*)(lds + C_SS);
    const int fr = lane & 15, g = lane >> 4, G = gridDim.x;
    for (int e = tid; e < 16 * 64; e += 512) VT[(128 + (e >> 6)) * TP + (e & 63)] = (e >> 6) == 0 ? (bf16_t)0x3F80 : (bf16_t)0;
    for (int p8 = tid; p8 < 15 * 16; p8 += 512) *(LAS u32x4*)(CT + (129 + (p8 >> 4)) * QP + (p8 & 15) * 8) = (u32x4){0u, 0u, 0u, 0u};
    __syncthreads();
    int it = blockIdx.x;
    if (it >= NGC * 4) return;
    CLoad L; c_issue(a, it >> 2, it & 3, tid, wave, lane, L);
    ConvW Wq, Wk; int hw = it & 3;
#define C_HLOAD() do { convw_load(a, PQ + hw * 128 + 2 * lane, Wq); convw_load(a, PK + hw * 128 + 2 * lane, Wk); } while (0)
    C_HLOAD();
    for (; it < NGC * 4; it += G) {
        const int gc = it >> 2, h = it & 3, row0 = gc * 64;
        if (h != hw) { hw = h; C_HLOAD(); }
        const float b = gate_cumsum(L.fg, lane);
        const float mprev = L.mprev;
        const float x = L.ig - b;
        float pm = x;
#pragma unroll
        for (int o = 1; o < 64; o <<= 1) { const float t = __shfl_up(pm, o); if (lane >= o) pm = fmaxf(pm, t); }
        const float mt = b + fmaxf(mprev, pm);
        const float winter = fexp(b + mprev - mt), bm = b - mt, em = fexp(-mt);
        {
            const int s0 = 8 * wave, ch = 2 * lane, sw = 8 * (ch >> 4);
            float q0[8], q1[8]; conv_math(Wq, L.uq, q0, q1);
#pragma unroll
            for (int j = 0; j < 8; ++j) *(LAS unsigned*)(Qs + (s0 + j) * QP + ch) = cvt_pk_bf16(q0[j], q1[j]);
            float k0[8], k1[8]; conv_math(Wk, L.uk, k0, k1);
#pragma unroll
            for (int j = 0; j < 8; ++j) *(LAS unsigned*)(Ks + (s0 + j) * QP + ch) = cvt_pk_bf16(k0[j] * 0.08838834764831845f, k1[j] * 0.08838834764831845f);
            store_vT(L.v, s0, VT, ch, sw);
#pragma unroll
            for (int i = 0; i < 5; ++i) { const int p8 = tid + 512 * i; if (p8 < 129 * 16) *(LAS u32x4*)(CT + (p8 >> 4) * QP + (p8 & 15) * 8) = L.ct[i]; }
        }
        u32x2 mo[4];
#pragma unroll
        for (int q = 0; q < 4; ++q) mo[q] = L.mo[q];
        __syncthreads();
        { const int itn = it + G < NGC * 4 ? it + G : it; c_issue(a, itn >> 2, itn & 3, tid, wave, lane, L); }
        const int tt = wave & 3, dh = wave >> 2;
        bf16x8 qB[4];
#pragma unroll
        for (int ks = 0; ks < 4; ++ks) qB[ks] = *(const LAS bf16x8*)(Qs + (16 * tt + fr) * QP + 32 * ks + 8 * g);
        f32x4 sacc[4];
#pragma unroll
        for (int i4 = 0; i4 < 4; ++i4) { sacc[i4] = (f32x4){0.f, 0.f, 0.f, 0.f};
#pragma unroll
            for (int ks = 0; ks < 4; ++ks) { const bf16x8 kA = *(const LAS bf16x8*)(Ks + (16 * i4 + fr) * QP + 32 * ks + 8 * g); sacc[i4] = MFMA16(kA, qB[ks], sacc[i4]); } }
        const int t = 16 * tt + fr;
        const float bm_t = __shfl(bm, t), wi_t = __shfl(winter, t), em_t = __shfl(em, t);
#pragma unroll
        for (int i4 = 0; i4 < 4; ++i4)
#pragma unroll
            for (int r = 0; r < 4; ++r) {
                const int s_ = 16 * i4 + 4 * g + r;
                const float xs = __shfl(x, s_);
                const float w = (s_ <= t) ? fexp(bm_t + xs) : 0.f;
                sacc[i4][r] *= w;
            }
        bf16x8 pB[2];
#pragma unroll
        for (int k2 = 0; k2 < 2; ++k2) pB[k2] = pack8(sacc[2 * k2], sacc[2 * k2 + 1]);
        f32x4 res[5];
#pragma unroll
        for (int q = 0; q < 5; ++q) {
            const int dvt = q < 4 ? 4 * dh + q : 8;
            f32x4 a1 = {0.f, 0.f, 0.f, 0.f}, a2 = {0.f, 0.f, 0.f, 0.f};
#pragma unroll
            for (int ks = 0; ks < 4; ++ks) { const bf16x8 cA = *(const LAS bf16x8*)(CT + (16 * dvt + fr) * QP + 32 * ks + 8 * g); a1 = MFMA16(cA, qB[ks], a1); }
#pragma unroll
            for (int k2 = 0; k2 < 2; ++k2) {
                const LAS bf16_t* vp = VT + (16 * dvt + fr) * TP; const int sw = 8 * (dvt & 7);
                const s16x4 lo = *(const LAS s16x4*)(vp + ((32 * k2 + 4 * g) ^ sw)), hi = *(const LAS s16x4*)(vp + ((32 * k2 + 16 + 4 * g) ^ sw));
                const bf16x8 vA = __builtin_shufflevector(lo, hi, 0, 1, 2, 3, 4, 5, 6, 7);
                a2 = MFMA16(vA, pB[k2], a2);
            }
            res[q] = a1 * wi_t + a2;
        }
        const float den = __shfl(res[4][0], fr);
        const float inv = 1.0f / fmaxf(fabsf(den), em_t);
        float ssq = 0.f;
#pragma unroll
        for (int q = 0; q < 4; ++q)
#pragma unroll
            for (int r = 0; r < 4; ++r) { const float hv = res[q][r] * inv; res[q][r] = hv; ssq += hv * hv; }
        ssq += __shfl_xor(ssq, 16); ssq += __shfl_xor(ssq, 32);
        f32x4 gm[4];
#pragma unroll
        for (int q = 0; q < 4; ++q) gm[q] = *(const f32x4*)(a.g_mlstm + h * 128 + 16 * (4 * dh + q) + 4 * g);
        if (g == 0) SS[dh * 64 + t] = ssq;
        __syncthreads();
        const float rs = 1.0f / sqrtf((SS[t] + SS[64 + t]) * (1.0f / 128.0f) + EPS);
#pragma unroll
        for (int q = 0; q < 4; ++q) {
            const int col = h * 128 + 16 * (4 * dh + q) + 4 * g;
            const float o0 = sigmoidf_(bflo(mo[q].x)) * res[q][0] * rs * gm[q][0], o1 = sigmoidf_(bfhi(mo[q].x)) * res[q][1] * rs * gm[q][1];
            const float o2 = sigmoidf_(bflo(mo[q].y)) * res[q][2] * rs * gm[q][2], o3 = sigmoidf_(bfhi(mo[q].y)) * res[q][3] * rs * gm[q][3];
            u32x2 w; w.x = cvt_pk_bf16(o0, o1); w.y = cvt_pk_bf16(o2, o3);
            *(u32x2*)(MIX + (size_t)(row0 + t) * DM + col) = w;
        }
        __syncthreads();
    }
#undef C_HLOAD
}

#define XB_TMO      128
#define XB_XCNT(j)  (256  + 64 * (j))
#define XB_XSUB(j)  (1280 + 64 * (j))
#define XB_XGEN(j)  (2304 + 64 * (j))
#define XB_TOP      3328
#define XB_TOPGEN   3392
#define XCD_BAR_WORDS 3456
#define XB_SPIN_CAP (1u << 18)

__device__ __forceinline__ unsigned xb_ld(unsigned* p)              { return __hip_atomic_load(p, __ATOMIC_RELAXED, __HIP_MEMORY_SCOPE_AGENT); }
__device__ __forceinline__ unsigned xb_add(unsigned* p, unsigned v) { return __hip_atomic_fetch_add(p, v, __ATOMIC_RELAXED, __HIP_MEMORY_SCOPE_AGENT); }
__device__ __forceinline__ unsigned xb_xcc_id() { return (unsigned)__builtin_amdgcn_s_getreg((3 << 11) | 20) & 0xFu; }
#define XB_SPIN(cond, bar) do { unsigned _sp = 0; while (cond) { __builtin_amdgcn_s_sleep(1); \
    if ((++_sp & 255u) == 0u) { if (xb_ld(&(bar)[XB_TMO])) break; if (_sp > XB_SPIN_CAP) { atomicAdd(&(bar)[XB_TMO], 1u); break; } } } } while (0)

struct XcdBarrier {
    unsigned* bar; unsigned x;
    volatile LAS unsigned* st;
};

__device__ __forceinline__ XcdBarrier xcd_barrier_post(unsigned* bar, volatile LAS unsigned* st) {
    XcdBarrier b; b.bar = bar; b.x = xb_xcc_id(); b.st = st;
    if (threadIdx.x == 0) (void)xb_add(&bar[XB_XCNT(b.x)], 1u);
    return b;
}
__device__ __forceinline__ void xcd_barrier_complete(unsigned* bar, unsigned x, unsigned& nloc, unsigned& nx) {
    const unsigned G = gridDim.x * gridDim.y * gridDim.z;
    unsigned sum, cnt, mine, sp = 0u;
    for (;;) {
        sum = 0u; cnt = 0u; mine = 0u;
#pragma unroll
        for (unsigned j = 0; j < 16; ++j) { const unsigned c = xb_ld(&bar[XB_XCNT(j)]); sum += c; cnt += (c > 0u) ? 1u : 0u; mine = (j == x) ? c : mine; }
        if (sum == G) break;
        __builtin_amdgcn_s_sleep(1);
        if ((++sp & 255u) == 0u) { if (xb_ld(&bar[XB_TMO])) break; if (sp > XB_SPIN_CAP) { atomicAdd(&bar[XB_TMO], 1u); break; } }
    }
    nloc = mine > 0u ? mine : 1u; nx = cnt > 0u ? cnt : 1u;
}

__device__ __forceinline__ void xcd_barrier(const XcdBarrier& b) {
    asm volatile("s_waitcnt vmcnt(0)" ::: "memory");
    __syncthreads();
    if (threadIdx.x == 0) {
        unsigned* bar = b.bar;
        __builtin_amdgcn_s_waitcnt(0);
        unsigned nloc = b.st[0], nx = b.st[1];
        if (nloc == 0u) { xcd_barrier_complete(bar, b.x, nloc, nx); b.st[0] = nloc; b.st[1] = nx; }
        const unsigned old = xb_add(&bar[XB_XSUB(b.x)], 1u);
        const unsigned gen = old / nloc;
        if (old + 1u == (gen + 1u) * nloc) {
            __builtin_amdgcn_fence(__ATOMIC_RELEASE, "agent");
            asm volatile("s_waitcnt vmcnt(0)" ::: "memory");
            const unsigned og = xb_add(&bar[XB_TOP], 1u);
            const unsigned tg = og / nx;
            if (og + 1u == (tg + 1u) * nx) xb_add(&bar[XB_TOPGEN], 1u);
            else XB_SPIN(xb_ld(&bar[XB_TOPGEN]) == tg, bar);
            __builtin_amdgcn_fence(__ATOMIC_ACQUIRE, "agent");
            xb_add(&bar[XB_XGEN(b.x)], 1u);
            asm volatile("s_waitcnt vmcnt(0)" ::: "memory");
        } else {
            XB_SPIN(xb_ld(&bar[XB_XGEN(b.x)]) == gen, bar);
            __builtin_amdgcn_fence(__ATOMIC_ACQUIRE, "agent");
            asm volatile("s_waitcnt vmcnt(0)" ::: "memory");
        }
    }
    __syncthreads();
}

constexpr int NPHASE = 14;
__global__ void __launch_bounds__(512, 2) fwd_megakernel(KArgs a) {
    extern __shared__ __attribute__((aligned(16))) unsigned char lds_raw[];
    LAS unsigned char* lds = (LAS unsigned char*)lds_raw;
    cg::grid_group grid = cg::this_grid();
    const int lo = a.ph_lo, hi = a.ph_hi;
    volatile LAS unsigned* bst = (volatile LAS unsigned*)(lds + BAR_LDS_OFF);
    if (threadIdx.x < 4) bst[threadIdx.x] = 0u;
    __syncthreads();
    XcdBarrier bar = xcd_barrier_post((unsigned*)a.ws, bst);
#define TIDS int tid = threadIdx.x; asm volatile("" : "+v"(tid)); const int lane = tid & 63, wave = __builtin_amdgcn_readfirstlane(tid >> 6); (void)lane; (void)wave
    const int G = gridDim.x;
    const float* mod = (const float*)(a.ws + WS_MOD);
    bf16_t* HN = (bf16_t*)(a.ws + WS_HN);
    bf16_t* ACT = (bf16_t*)(a.ws + WS_PROJ);
    bf16_t* PROJ = (bf16_t*)(a.ws + WS_PROJ);
    bf16_t* XB = (bf16_t*)a.out + (size_t)M * DM;
    constexpr bool FUSE_NORM = true;
    bf16_t* XB2 = (bf16_t*)(a.ws + WS_CST);
    float* PART = (float*)(a.ws + WS_UT);
    float* XS4 = (float*)(a.ws + WS_XS); float* XS5 = XS4 + (size_t)MS * DM;
#define IN(k) (lo <= (k) && (k) < hi)
#define SEAM(k) do { if (IN(k) && IN((k) + 1)) xcd_barrier(bar); } while (0)
    if (lo < 0) grid.sync();

    if (IN(0)) for (int rep = 0; rep < (DBG_REP == 0 ? 2 : 1); ++rep) { if (rep) grid.sync(); { TIDS; phase_prologue(a, lds, tid, wave, lane); } }
    SEAM(0);
    if (IN(1)) for (int rep = 0; rep < (DBG_REP == 1 ? 2 : 1); ++rep) { if (rep) grid.sync(); { TIDS; phase_norm<false, 0, false>(a, a.x_prompt, nullptr, a.x_sample, nullptr, a.g_norm, 0 * DM, 1 * DM, 0, 0.f, 0, lds, tid, wave, lane); } }
    SEAM(1);
    if (IN(2)) for (int rep = 0; rep < (DBG_REP == 2 ? 2 : 1); ++rep) { if (rep) grid.sync(); { pg8::Gemm g{HN, (const bf16_t*)(a.ws + WS_WUP1), M, NUP, DM}; pg8::StaticOrder S; S.init(M, NUP, G, (int)blockIdx.x, DM);
        pg8::EpiSwiglu E{ACT}; pg8::gemm_phase<pg8::EpiSwiglu, pg8::StaticOrder, true, true>(lds, g, S, E);
        { TIDS; const int thr = S.nwg % G, c = (int)blockIdx.x; if (rep == 0 && c >= thr) convert_group(a, 1, (c - thr) * 8 + wave, (G - thr) * 8, lds, wave, lane); } } }
    SEAM(2);
    if (IN(3)) for (int rep = 0; rep < (DBG_REP == 3 ? 2 : 1); ++rep) { if (rep) grid.sync(); { pg8::Gemm g{ACT, (const bf16_t*)(a.ws + WS_WDN1), M, DM, DFF}; pg8::SplitOrder S; S.init(DM, G, (int)blockIdx.x, DFF, 4);
        pg8::EpiResidT<false> E{a.x_prompt, nullptr, XB, mod, 2 * DM, 0.5f, PART}; pg8::gemm_phase<pg8::EpiResidT<false>, pg8::SplitOrder, true, true>(lds, g, S, E);
        { TIDS; const int thr = (S.P.nwg + S.NS * (MS / 256) * S.P.nN) % G, c = (int)blockIdx.x; if (rep == 0 && c >= thr) convert_group(a, 2, (c - thr) * 8 + wave, (G - thr) * 8, lds, wave, lane); } } }
    SEAM(3);
    if (IN(4)) for (int rep = 0; rep < (DBG_REP == 4 ? 2 : 1); ++rep) { if (rep) grid.sync(); { TIDS; phase_norm<true, 4, true>(a, nullptr, XB, a.x_sample, XS5, a.g_norm + DM, 3 * DM, 4 * DM, 2 * DM, 0.5f, 0, lds, tid, wave, lane); } }
    SEAM(4);
    if (IN(5)) for (int rep = 0; rep < (DBG_REP == 5 ? 2 : 1); ++rep) { if (rep) grid.sync(); { pg8::Gemm g{HN, (const bf16_t*)(a.ws + WS_WIN), M, NPROJ, DM}; pg8::StaticOrder S; S.init(M, NPROJ, G, (int)blockIdx.x, DM);
        pg8::EpiProj E{PROJ, a.out}; pg8::gemm_phase<pg8::EpiProj, pg8::StaticOrder, true, true>(lds, g, S, E);
        { TIDS; (void)lane; (void)wave; const int thr = S.nwg % G, c = (int)blockIdx.x; if (rep == 0 && c >= thr) kvc_convert(a, (c - thr) * 512 + tid, (G - thr) * 512); } } }
    SEAM(5);
    if (IN(6)) for (int rep = 0; rep < (DBG_REP == 6 ? 2 : 1); ++rep) { if (rep) grid.sync(); { TIDS; phase_mixA(a, lds, tid, wave, lane); } }
    SEAM(6);
    if (IN(7)) for (int rep = 0; rep < (DBG_REP == 7 ? 2 : 1); ++rep) { if (rep) grid.sync(); { TIDS; LAS float* tab = (LAS float*)(lds + TAB_OFF); for (int i = tid; i < 8 * 256; i += 512) { const int e = i & 255; tab[i] = a.rel_tab[(i >> 8) * 192 + (e > 191 ? 191 : e)] * LOG2E; } __syncthreads();
        phase_scan(a, tid);
        const int nscan = (8 * (129 * 128 / 4) + 511) / 512;
        if ((int)blockIdx.x >= nscan && G > nscan) for (int it = (int)blockIdx.x - nscan; it < ATT_N7; it += G - nscan) attn_item(a, it, lds, wave, lane); } }
    SEAM(7);
    if (IN(8)) for (int rep = 0; rep < (DBG_REP == 8 ? 2 : 1); ++rep) { if (rep) grid.sync(); { TIDS; phase_mixC(a, lds, tid, wave, lane); } }
    SEAM(8);
    if (IN(9)) for (int rep = 0; rep < (DBG_REP == 9 ? 2 : 1); ++rep) { if (rep) grid.sync(); { pg8::Gemm g{HN, (const bf16_t*)(a.ws + WS_WOUT), M, DM, DM}; pg8::SplitOrder S; S.init(DM, G, (int)blockIdx.x, DM, 2);
        pg8::EpiResidNorm<2> E{XB, XB2, nullptr, mod, PART, a.g_norm + 2 * DM, a.ws}; pg8::gemm_phase<pg8::EpiResidNorm<2>, pg8::SplitOrder, true, true>(lds, g, S, E);
        { TIDS; (void)lane; (void)wave; norm_tail(S, XB2, HN, mod, a.g_norm + 2 * DM, a.ws, lds, tid); } } }
    SEAM(9);
    if (IN(10)) for (int rep = 0; rep < (DBG_REP == 10 ? 2 : 1); ++rep) { if (rep) grid.sync(); { TIDS; phase_norm<false, 2, true>(a, nullptr, XB2, XS5, XS4, a.g_norm + 2 * DM, 6 * DM, 7 * DM, 5 * DM, 1.0f, MP, lds, tid, wave, lane); } }
    SEAM(10);
    if (IN(11)) for (int rep = 0; rep < (DBG_REP == 11 ? 2 : 1); ++rep) { if (rep) grid.sync(); { pg8::Gemm g{HN, (const bf16_t*)(a.ws + WS_WUP2), M, NUP, DM}; pg8::StaticOrder S; S.init(M, NUP, G, (int)blockIdx.x, DM);
        pg8::EpiSwiglu E{ACT}; pg8::gemm_phase<pg8::EpiSwiglu, pg8::StaticOrder, true, true>(lds, g, S, E); } }
    SEAM(11);
    if (IN(12)) for (int rep = 0; rep < (DBG_REP == 12 ? 2 : 1); ++rep) { if (rep) grid.sync(); { pg8::Gemm g{ACT, (const bf16_t*)(a.ws + WS_WDN2), M, DM, DFF}; pg8::SplitOrder S; S.init(DM, G, (int)blockIdx.x, DFF, 4);
        pg8::EpiResidNorm<0> E{XB2, HN, (void*)a.out, mod, PART, a.g_final, a.ws}; pg8::gemm_phase<pg8::EpiResidNorm<0>, pg8::SplitOrder, true, true>(lds, g, S, E); } }
    SEAM(12);
    if (IN(13)) for (int rep = 0; rep < (DBG_REP == 13 ? 2 : 1); ++rep) { if (rep) grid.sync(); { TIDS; phase_final_norm(a, HN, XS4, FUSE_NORM ? MP : 0, wave, lane); } }

    if (DBG_REP == 100) { for (int r = 0; r < 13; ++r) grid.sync(); }
#undef IN
#undef SEAM
}

extern "C" void kernel_launch(void* const* d_in, const int* in_sizes, int n_in, void* d_out, int out_size, void* d_ws, size_t ws_size, hipStream_t stream) {
    static int grid = 0;
    if (grid == 0) {
        if (n_in != 25 || (size_t)out_size != OUT_TOTAL || ws_size < WS_END) { fprintf(stderr, "kernel_launch: unexpected shapes: n_in %d out %d ws %zu\n", n_in, out_size, ws_size); grid = -1; return; }
        int dev = 0, cus = 0, per_cu = 0;
        hipGetDevice(&dev);
        hipDeviceGetAttribute(&cus, hipDeviceAttributeMultiprocessorCount, dev);
        hipFuncSetAttribute((const void*)fwd_megakernel, hipFuncAttributeMaxDynamicSharedMemorySize, LDS_BYTES);
        hipOccupancyMaxActiveBlocksPerMultiprocessor(&per_cu, (const void*)fwd_megakernel, 512, LDS_BYTES);
        if (per_cu < 1) { fprintf(stderr, "kernel_launch: occupancy query says %d blocks per CU\n", per_cu); per_cu = 1; }
        (void)hipGetLastError();
        grid = cus * per_cu;
    }
    if (grid < 0) return;
    if (hipMemsetAsync(d_ws, 0, CTL_ZERO_BYTES, stream) != hipSuccess) { fprintf(stderr, "kernel_launch: memset failed\n"); return; }
    KArgs a{};
    const float** f = (const float**)&a;
    for (int i = 0; i < 25; ++i) f[i] = (const float*)d_in[i];
    a.out = (float*)d_out; a.ws = (unsigned char*)d_ws;
#if MK_MULTI
    hipMemsetAsync(d_out, 0, (size_t)out_size * 4, stream);
    for (int p = 0; p < DBG_NPH; ++p) {
        a.ph_lo = p; a.ph_hi = p + 1;
        void* args[] = {&a};
        hipError_t e = hipLaunchCooperativeKernel((const void*)fwd_megakernel, dim3(grid), dim3(512), args, LDS_BYTES, stream);
        if (e != hipSuccess) { fprintf(stderr, "launch %d failed: %s\n", p, hipGetErrorString(e)); break; }
    }
#else
    a.ph_lo = 0; a.ph_hi = NPHASE;
    void* args[] = {&a};
    hipError_t e = hipLaunchCooperativeKernel((const void*)fwd_megakernel, dim3(grid), dim3(512), args, LDS_BYTES, stream);
    if (e != hipSuccess) fprintf(stderr, "cooperative launch failed: %s (grid %d)\n", hipGetErrorString(e), grid);
#endif
}
```

```cpp
#include <hip/hip_runtime.h>
#include <hip/hip_cooperative_groups.h>
#include <cstdio>
#include <cstdint>
namespace cg = cooperative_groups;

#ifndef MK_MULTI
#define MK_MULTI 0
#ifndef DBG_NPH
#define DBG_NPH 14
#endif
#endif

#ifndef DBG_REP
#define DBG_REP -1
#endif
#define DI __device__ __forceinline__
#define LAS __attribute__((address_space(3)))
typedef unsigned short bf16_t;
typedef short bf16x8 __attribute__((ext_vector_type(8)));
typedef short s16x4 __attribute__((ext_vector_type(4)));
typedef float f32x4 __attribute__((ext_vector_type(4)));
typedef unsigned u32x4 __attribute__((ext_vector_type(4)));
typedef unsigned u32x2 __attribute__((ext_vector_type(2)));

constexpr int DM = 1024, SEQ = 16384, NB = 2, DECB = 32, DECS = 64;
constexpr int MP = NB * SEQ, MS = DECB * DECS, M = MP + MS;
constexpr int DFF = 2816, NUP = 2 * DFF, DIN = 3592, NPROJ = 3584, NMOD = 9 * DM;
constexpr int NGC = M / 64;
constexpr int PQ = 0, PK = 512, PV = 1024, PO = 1536, PAQ = 2048, PAK = 2560, PAV = 3072;
constexpr float EPS = 1e-6f;
constexpr float LOG2E = 1.4426950408889634f;
constexpr size_t OFF_Y = 0, OFF_C_P = (size_t)M * DM, OFF_N_P = OFF_C_P + 131072, OFF_M_P = OFF_N_P + 1024, OFF_CONV_P = OFF_M_P + 8,
                 OFF_AK_P = OFF_CONV_P + 6144, OFF_AV_P = OFF_AK_P + 524288, OFF_C_S = OFF_AV_P + 524288, OFF_N_S = OFF_C_S + 2097152,
                 OFF_M_S = OFF_N_S + 16384, OFF_CONV_S = OFF_M_S + 128, OFF_AK_S = OFF_CONV_S + 98304, OFF_AV_S = OFF_AK_S + 1048576,
                 OUT_TOTAL = OFF_AV_S + 1048576;
constexpr size_t MiB = 1u << 20;
constexpr size_t WS_PREVB = 512 * 1024;
constexpr size_t WS_MOD = 1 * MiB, WS_WUP1 = 3 * MiB, WS_WDN1 = 14 * MiB, WS_WUP2 = 20 * MiB, WS_WDN2 = 31 * MiB, WS_WIN = 37 * MiB, WS_WOUT = 44 * MiB,
                 WS_GATES = 46 * MiB, WS_CHK = 48 * MiB, WS_HN = 49 * MiB, WS_PROJ = 117 * MiB, WS_UT = 355 * MiB, WS_CST = 424 * MiB, WS_XS = 494 * MiB, WS_END = 510 * MiB;
static_assert(WS_HN + (size_t)M * DM * 2 <= WS_PROJ && WS_PROJ + (size_t)M * NPROJ * 2 <= WS_UT && WS_UT + (size_t)NGC * 4 * 129 * 128 * 2 <= WS_CST &&
              WS_CST + (size_t)NGC * 4 * 129 * 128 * 2 <= WS_XS && WS_XS + (size_t)2 * MS * DM * 4 <= WS_END, "ws map");
constexpr int LDS_BYTES = 147456;
constexpr int TAB_OFF = 131072;
constexpr int BAR_LDS_OFF = LDS_BYTES - 64;
constexpr size_t CTL_ZERO_BYTES = 512 * 1024;
constexpr size_t CTL_SSQ_A = 64 * 1024, CTL_SSQ_B = 192 * 1024, CTL_CNT_A = 320 * 1024, CTL_CNT_B = 336 * 1024;

typedef float f32x2_t __attribute__((ext_vector_type(2))); typedef __bf16 bf16x2_t __attribute__((ext_vector_type(2)));
DI unsigned cvt_pk_bf16(float lo, float hi) { f32x2_t v = {lo, hi}; bf16x2_t b = __builtin_convertvector(v, bf16x2_t); return __builtin_bit_cast(unsigned, b); }
DI unsigned cvt_pk_asm(float lo, float hi) { unsigned r; asm volatile("v_cvt_pk_bf16_f32 %0, %1, %2" : "=v"(r) : "v"(lo), "v"(hi)); return r; }
DI float bf2f(unsigned short h) { return __uint_as_float((unsigned)h << 16); }
DI float bflo(unsigned w) { return __uint_as_float(w << 16); }
DI float bfhi(unsigned w) { return __uint_as_float(w & 0xffff0000u); }
DI float wave_sum(float v) {
#pragma unroll
    for (int o = 1; o < 64; o <<= 1) v += __shfl_xor(v, o);
    return v;
}
DI float wave_max(float v) {
#pragma unroll
    for (int o = 1; o < 64; o <<= 1) v = fmaxf(v, __shfl_xor(v, o));
    return v;
}
DI int modrow(int row) { return row < MP ? (row >> 14) : 2 + ((row - MP) >> 6); }
DI float fexp2(float x) { return __builtin_amdgcn_exp2f(x); }
DI float fexp(float x) { return __builtin_amdgcn_exp2f(x * 1.4426950408889634f); }
DI float frcp(float x) { return __builtin_amdgcn_rcpf(x); }
DI float sigmoidf_(float x) { return frcp(1.0f + fexp(-x)); }
DI float siluf_(float x) { return x * frcp(1.0f + fexp(-x)); }
#define MFMA16(a, b, c) __builtin_amdgcn_mfma_f32_16x16x32_bf16((a), (b), (c), 0, 0, 0)

namespace pg8 {
constexpr int BM = 256, BK = 64, HALF = 128, HTB = HALF * BK * 2, STAGE_BYTES = 8 * HTB, NXCD = 8, WGM = 8;
DI int lds_byte(int r, int c) { const int st = (r >> 4) * 2 + (c >> 5), rr = r & 15, cc = c & 31, ob = rr * 64 + cc * 2; return st * 1024 + (ob ^ (((ob >> 9) & 1) << 5)); }
DI void stage_rc(int b, int& R, int& C) { const int st = b / 1024, sb = b % 1024, swz = sb ^ (((sb >> 9) & 1) << 5); R = (st >> 1) * 16 + swz / 64; C = (st & 1) * 32 + (swz % 64) / 2; }
DI int perm32(int rho) { const int n = rho >> 4, i = rho & 15; return 8 * (i >> 2) + 4 * n + (i & 3); }
struct Unit { int pm, pn, k0, nt, part; };
struct Gemm { const bf16_t* A; const bf16_t* Bt; int M, N, K; };
struct StaticOrder {
    int nM, nN, nwg, G, c, ntk;
    DI void init(int M_, int N_, int G_, int c_, int K_) { nM = M_ / BM; nN = N_ / BM; nwg = nM * nN; G = G_; c = c_; ntk = K_ / BK; }
    DI void calc(int wg, int& pm, int& pn) const {
        int wgid = wg; { const int q = nwg / NXCD, r = nwg % NXCD, xcd = wgid % NXCD, off = wgid / NXCD; wgid = (xcd < r ? xcd * (q + 1) : r * (q + 1) + (xcd - r) * q) + off; }
        const int nig = WGM * nN, gid = wgid / nig, fm = gid * WGM, gsz = (nM - fm) < WGM ? (nM - fm) : WGM;
        pm = fm + ((wgid % nig) % gsz); pn = (wgid % nig) / gsz;
    }
    DI bool next(int i, Unit& u) const {
        const long L = (long)i * G + c; if (L >= nwg) return false;
        int wgid = (int)L; { const int q = nwg / NXCD, r = nwg % NXCD, xcd = wgid % NXCD, off = wgid / NXCD; wgid = (xcd < r ? xcd * (q + 1) : r * (q + 1) + (xcd - r) * q) + off; }
        const int nig = WGM * nN, gid = wgid / nig, fm = gid * WGM, gsz = (nM - fm) < WGM ? (nM - fm) : WGM;
        u.pm = fm + ((wgid % nig) % gsz); u.pn = (wgid % nig) / gsz; u.k0 = 0; u.nt = ntk; u.part = -1; return true;
    }
    DI void a_ready(const Unit&) const {}
    DI void done(const Unit&) const {}
};

struct SplitOrder {
    StaticOrder P; int NS, q1, q3;
    DI void init(int N_, int G_, int c_, int K_, int NS_) { P.init(MP, N_, G_, c_, K_); NS = NS_; const int nt = K_ / BK;
        if (NS_ == 4) { q1 = ((nt / 4) + 1) & ~1; q3 = 2 * q1 + (((nt - 2 * q1) / 2) & ~1); } else { q1 = nt / 2; q3 = nt; } }
    DI bool next(int i, Unit& u) const {
        const long L = (long)i * P.G + P.c;
        const int per = (MS / BM) * P.nN, total = P.nwg + NS * per;
        const bool isp = L < P.nwg;
        const int Lc = (int)(L < total ? L : total - 1);
        int ppm, ppn; P.calc(isp ? Lc : 0, ppm, ppn);
        const int j = isp ? 0 : Lc - P.nwg, part = j / per, rem = j % per;
        const int b = part == 3 ? q3 : part * q1;
        const int e = part == NS - 1 ? P.ntk : (part == 2 ? q3 : (part + 1) * q1);
        u.pm = isp ? ppm : MP / BM + rem / P.nN; u.pn = isp ? ppn : rem % P.nN; u.part = isp ? -1 : part; u.k0 = isp ? 0 : b; u.nt = isp ? P.ntk : e - b;
        return L < total;
    }
    DI void a_ready(const Unit&) const {}
    DI void done(const Unit&) const {}
};


struct EpiSwiglu {
    static constexpr bool PERM = true, AFTER_DRAIN = false;
    bf16_t* O;
    DI void operator()(const f32x4 (&acc)[2][2][4][2], const Unit& u, int wr, int wc, int fr, int fq) const {
        const int row0 = u.pm * BM + wr * 64 + fr, col0 = u.pn * HALF + wc * 32 + 8 * fq;
#pragma unroll
        for (int ai = 0; ai < 2; ++ai)
#pragma unroll
            for (int m = 0; m < 4; ++m) {
                bf16_t* p = O + (size_t)(row0 + ai * HALF + m * 16) * DFF + col0;
                f32x4 o4[2];
#pragma unroll
                for (int n = 0; n < 2; ++n) {
                    const f32x4 g4 = acc[ai][0][m][n], u4 = acc[ai][1][m][n];
                    const f32x4 t = g4 * (-LOG2E);
                    f32x4 e; e[0] = __builtin_amdgcn_exp2f(t[0]); e[1] = __builtin_amdgcn_exp2f(t[1]); e[2] = __builtin_amdgcn_exp2f(t[2]); e[3] = __builtin_amdgcn_exp2f(t[3]);
                    const f32x4 d = e + 1.0f;
                    f32x4 r; r[0] = __builtin_amdgcn_rcpf(d[0]); r[1] = __builtin_amdgcn_rcpf(d[1]); r[2] = __builtin_amdgcn_rcpf(d[2]); r[3] = __builtin_amdgcn_rcpf(d[3]);
                    o4[n] = (g4 * u4) * r;
                }
                u32x4 w; w.x = cvt_pk_asm(o4[0][0], o4[0][1]); w.y = cvt_pk_asm(o4[0][2], o4[0][3]); w.z = cvt_pk_asm(o4[1][0], o4[1][1]); w.w = cvt_pk_asm(o4[1][2], o4[1][3]);
                *(u32x4*)p = w;
            }
    }
};
template <bool B16IN>
struct EpiResidT {
    static constexpr bool PERM = true, AFTER_DRAIN = false;
    const float* base_f; const bf16_t* base_h; bf16_t* out_h; const float* mod; int gate_off; float coef; float* part;
    DI void operator()(const f32x4 (&acc)[2][2][4][2], const Unit& u, int wr, int wc, int fr, int fq) const {
        const int row0 = u.pm * BM + wr * 64 + fr, col0 = u.pn * BM + wc * 32 + 8 * fq;
        if (u.part >= 0) {
#pragma unroll
            for (int ai = 0; ai < 2; ++ai)
#pragma unroll
                for (int m = 0; m < 4; ++m) {
                    float* op = part + ((size_t)u.part * MS + (size_t)(row0 + ai * HALF + m * 16 - MP)) * DM;
#pragma unroll
                    for (int bj = 0; bj < 2; ++bj)
#pragma unroll
                        for (int n = 0; n < 2; ++n) *(f32x4*)(op + col0 + bj * HALF + 4 * n) = acc[ai][bj][m][n];
                }
            return;
        }
#pragma unroll
        for (int ai = 0; ai < 2; ++ai)
#pragma unroll
            for (int m = 0; m < 4; ++m) {
                const int row = row0 + ai * HALF + m * 16;
                const float* gp = mod + (size_t)(row >> 14) * NMOD + gate_off;
#pragma unroll
                for (int bj = 0; bj < 2; ++bj) {
                    const int c = col0 + bj * HALF;
                    f32x4 b0, b1;
                    if (B16IN) { const u32x4 w = *(const u32x4*)(base_h + (size_t)row * DM + c);
                        b0 = (f32x4){bflo(w.x), bfhi(w.x), bflo(w.y), bfhi(w.y)}; b1 = (f32x4){bflo(w.z), bfhi(w.z), bflo(w.w), bfhi(w.w)}; }
                    else { b0 = *(const f32x4*)(base_f + (size_t)row * DM + c); b1 = *(const f32x4*)(base_f + (size_t)row * DM + c + 4); }
                    const f32x4 g0 = *(const f32x4*)(gp + c), g1 = *(const f32x4*)(gp + c + 4);
                    const f32x4 o0 = b0 + (g0 * coef) * acc[ai][bj][m][0], o1 = b1 + (g1 * coef) * acc[ai][bj][m][1];
                    u32x4 w; w.x = cvt_pk_asm(o0[0], o0[1]); w.y = cvt_pk_asm(o0[2], o0[3]); w.z = cvt_pk_asm(o1[0], o1[1]); w.w = cvt_pk_asm(o1[2], o1[3]);
                    *(u32x4*)(out_h + (size_t)row * DM + c) = w;
                }
            }
    }
};
template <int MODE>
struct EpiResidNorm {
    static constexpr bool PERM = true, AFTER_DRAIN = false;
    const bf16_t* base_h; bf16_t* out_h; void* dst; const float* mod; float* part; const float* g; unsigned char* ctl;
    static constexpr int gate_off = MODE == 0 ? 8 * DM : 5 * DM, shift_off = 6 * DM, scale_off = 7 * DM;
    static constexpr float coef = MODE == 0 ? 0.5f : 1.0f;
    DI void operator()(const f32x4 (&acc)[2][2][4][2], const Unit& u, int wr, int wc, int fr, int fq) const {
        float* sumsq = (float*)(ctl + (MODE == 0 ? CTL_SSQ_B : CTL_SSQ_A)); unsigned* cnt = (unsigned*)(ctl + (MODE == 0 ? CTL_CNT_B : CTL_CNT_A));
        float* y = (float*)dst; bf16_t* hn = (bf16_t*)dst;
        const int row0 = u.pm * BM + wr * 64 + fr, col0 = u.pn * BM + wc * 32 + 8 * fq;
        if (u.part >= 0) {
#pragma unroll
            for (int ai = 0; ai < 2; ++ai)
#pragma unroll
                for (int m = 0; m < 4; ++m) {
                    float* op = part + ((size_t)u.part * MS + (size_t)(row0 + ai * HALF + m * 16 - MP)) * DM;
#pragma unroll
                    for (int bj = 0; bj < 2; ++bj)
#pragma unroll
                        for (int n = 0; n < 2; ++n) *(f32x4*)(op + col0 + bj * HALF + 4 * n) = acc[ai][bj][m][n];
                }
            return;
        }
        const float* md = mod + (size_t)(row0 >> 14) * NMOD;
        const unsigned rb = (unsigned)(row0 * DM + col0);
        float ssq[8];
#pragma unroll
        for (int k = 0; k < 8; ++k) ssq[k] = 0.f;
#pragma unroll
        for (int bj = 0; bj < 2; ++bj) {
            const int c = col0 + bj * HALF;
            const f32x4 g0 = *(const f32x4*)(md + gate_off + c) * coef, g1 = *(const f32x4*)(md + gate_off + c + 4) * coef;
#pragma unroll
            for (int ai = 0; ai < 2; ++ai)
#pragma unroll
                for (int m = 0; m < 4; ++m) {
                    const unsigned eo = rb + (unsigned)((ai * HALF + m * 16) * DM + bj * HALF);
                    const u32x4 w = *(const u32x4*)((const char*)base_h + eo * 2u);
                    const f32x4 b0 = {bflo(w.x), bfhi(w.x), bflo(w.y), bfhi(w.y)}, b1 = {bflo(w.z), bfhi(w.z), bflo(w.w), bfhi(w.w)};
                    const f32x4 x0 = b0 + g0 * acc[ai][bj][m][0], x1 = b1 + g1 * acc[ai][bj][m][1];
                    ssq[ai * 4 + m] += (x0[0] * x0[0] + x0[1] * x0[1]) + (x0[2] * x0[2] + x0[3] * x0[3]) + (x1[0] * x1[0] + x1[1] * x1[1]) + (x1[2] * x1[2] + x1[3] * x1[3]);
                    u32x4 p; p.x = cvt_pk_bf16(x0[0], x0[1]); p.y = cvt_pk_bf16(x0[2], x0[3]); p.z = cvt_pk_bf16(x1[0], x1[1]); p.w = cvt_pk_bf16(x1[2], x1[3]);
                    *(u32x4*)((char*)out_h + eo * 2u) = p;
                }
        }
#pragma unroll
        for (int k = 0; k < 8; ++k) { float s = ssq[k]; s += __shfl_xor(s, 16); s += __shfl_xor(s, 32); ssq[k] = s; }
        if (fq == 0) {
#pragma unroll
            for (int k = 0; k < 8; ++k) (void)__hip_atomic_fetch_add(sumsq + row0 + (k >> 2) * HALF + (k & 3) * 16, ssq[k], __ATOMIC_RELAXED, __HIP_MEMORY_SCOPE_AGENT);
        }
        asm volatile("s_waitcnt vmcnt(0)" ::: "memory");
        unsigned* cw = cnt + 16 * u.pm;
        if (fq == 0 && fr == 0) (void)__hip_atomic_fetch_add(cw, 1u, __ATOMIC_RELAXED, __HIP_MEMORY_SCOPE_AGENT);
        { unsigned sp = 0; while ((unsigned)__builtin_amdgcn_readfirstlane(__hip_atomic_load(cw, __ATOMIC_RELAXED, __HIP_MEMORY_SCOPE_AGENT)) < 32u) { __builtin_amdgcn_s_sleep(2); if (++sp > (1u << 20)) break; } }
        asm volatile("" ::: "memory");
        float rstd[8];
#pragma unroll
        for (int k = 0; k < 8; ++k) { const float t = __hip_atomic_load(sumsq + row0 + (k >> 2) * HALF + (k & 3) * 16, __ATOMIC_RELAXED, __HIP_MEMORY_SCOPE_AGENT); rstd[k] = __builtin_amdgcn_rsqf(t * (1.0f / DM) + EPS); }
#pragma unroll
        for (int bj = 0; bj < 2; ++bj) {
            const int c = col0 + bj * HALF;
            f32x4 A0 = *(const f32x4*)(g + c), A1 = *(const f32x4*)(g + c + 4), B0 = {0.f, 0.f, 0.f, 0.f}, B1 = {0.f, 0.f, 0.f, 0.f};
            if (MODE == 1) { A0 = A0 * (*(const f32x4*)(md + scale_off + c) + 1.0f); A1 = A1 * (*(const f32x4*)(md + scale_off + c + 4) + 1.0f); B0 = *(const f32x4*)(md + shift_off + c); B1 = *(const f32x4*)(md + shift_off + c + 4); }
#pragma unroll
            for (int ai = 0; ai < 2; ++ai)
#pragma unroll
                for (int m = 0; m < 4; ++m) {
                    const unsigned eo = rb + (unsigned)((ai * HALF + m * 16) * DM + bj * HALF); const float rs = rstd[ai * 4 + m];
                    const u32x4 p = *(const u32x4*)((const char*)out_h + eo * 2u);
                    const f32x4 x0 = {bflo(p.x), bfhi(p.x), bflo(p.y), bfhi(p.y)}, x1 = {bflo(p.z), bfhi(p.z), bflo(p.w), bfhi(p.w)};
                    if (MODE == 0) {
                        *(f32x4*)((char*)y + eo * 4u) = (x0 * rs) * A0; *(f32x4*)((char*)y + eo * 4u + 16u) = (x1 * rs) * A1;
                    } else {
                        const f32x4 h0 = (x0 * rs) * A0 + B0, h1 = (x1 * rs) * A1 + B1;
                        u32x4 v; v.x = cvt_pk_bf16(h0[0], h0[1]); v.y = cvt_pk_bf16(h0[2], h0[3]); v.z = cvt_pk_bf16(h1[0], h1[1]); v.w = cvt_pk_bf16(h1[2], h1[3]);
                        *(u32x4*)((char*)hn + eo * 2u) = v;
                    }
                }
        }
    }
};
struct EpiProj {
    static constexpr bool PERM = true, AFTER_DRAIN = false;
    bf16_t* P; float* dout;
    DI void operator()(const f32x4 (&acc)[2][2][4][2], const Unit& u, int wr, int wc, int fr, int fq) const {
        const int row0 = u.pm * BM + wr * 64 + fr, col0 = u.pn * BM + wc * 32 + 8 * fq;
#pragma unroll
        for (int ai = 0; ai < 2; ++ai)
#pragma unroll
            for (int m = 0; m < 4; ++m) {
                const int row = row0 + ai * HALF + m * 16;
#pragma unroll
                for (int bj = 0; bj < 2; ++bj) {
                    const int col = col0 + bj * HALF;
                    const f32x4 v0 = acc[ai][bj][m][0], v1 = acc[ai][bj][m][1];
                    u32x4 w; w.x = cvt_pk_asm(v0[0], v0[1]); w.y = cvt_pk_asm(v0[2], v0[3]); w.z = cvt_pk_asm(v1[0], v1[1]); w.w = cvt_pk_asm(v1[2], v1[3]);
                    *(u32x4*)(P + (size_t)row * NPROJ + col) = w;
                    float* dst = nullptr;
                    if (col < 1024) {
                        if (row < MP) { const int t = row & (SEQ - 1); if (t >= SEQ - 3) dst = dout + OFF_CONV_P + (size_t)((row >> 14) * 3 + (t - (SEQ - 3))) * 1024 + col; }
                        else { const int t = (row - MP) & 63; if (t >= 61) dst = dout + OFF_CONV_S + (size_t)(((row - MP) >> 6) * 3 + (t - 61)) * 1024 + col; }
                    } else if (col >= PAK) {
                        const bool isv = col >= PAV; const int cc = col - (isv ? PAV : PAK);
                        if (row < MP) { const int t = row & (SEQ - 1); if (t >= SEQ - 512) dst = dout + (isv ? OFF_AV_P : OFF_AK_P) + (size_t)((row >> 14) * 512 + (t - (SEQ - 512))) * 512 + cc; }
                        else dst = dout + (isv ? OFF_AV_S : OFF_AK_S) + (size_t)(row - MP) * 512 + cc;
                    }
                    if (dst) { *(f32x4*)dst = v0; *(f32x4*)(dst + 4) = v1; }
                }
            }
    }
};

template <class Epi, class Sched, bool ALIGN_EPI = false, bool SP2 = false>
DI void gemm_phase(LAS unsigned char* lds, const Gemm g, const Sched& S, const Epi& E) {
    const int tid = threadIdx.x, wid = __builtin_amdgcn_readfirstlane(tid >> 6), lane = tid & 63, wr = wid >> 2, wc = wid & 3, fr = lane & 15, fq = lane >> 4;
    const int K = g.K;
    unsigned voffA[2], voffB[2];
#pragma unroll
    for (int i = 0; i < 2; ++i) { int R, C; stage_rc(tid * 16 + i * 8192, R, C); const int Rb = Epi::PERM ? ((R & ~31) + perm32(R & 31)) : R;
        voffA[i] = (unsigned)(R * K + C) * 2u; voffB[i] = (unsigned)(Rb * K + C) * 2u; }
    const size_t kstep = (size_t)(BK * 2);
    const size_t hstep = (size_t)HALF * K * 2;
    const size_t tstep = 2 * hstep;
    const unsigned ldsw = (unsigned)wid * 1024u;
    const int aoff = lds_byte(wr * 64 + fr, fq * 8), boff = lds_byte(wc * 32 + fr, fq * 8);
#define PG8_SA(b, h) (((b) * 2 + (h)) * HTB)
#define PG8_SB(b, h) ((4 + (b) * 2 + (h)) * HTB)
#define PG8_STAGE(bufoff, gbase, voff) do { _Pragma("unroll") for (int _i = 0; _i < 2; ++_i) \
        __builtin_amdgcn_global_load_lds((const unsigned*)((const char*)(gbase) + (voff)[_i]), (LAS unsigned*)(lds + (bufoff) + ldsw + _i * 8192), 16, 0, 0); } while (0)
#define PG8_LDA(dst, b, h) do { _Pragma("unroll") for (int m = 0; m < 4; ++m) _Pragma("unroll") for (int k = 0; k < 2; ++k) dst[m][k] = *(const LAS bf16x8*)(lds + PG8_SA(b, h) + aoff + m * 2048 + k * 1024); } while (0)
#define PG8_LDB(dst, b, h) do { _Pragma("unroll") for (int n = 0; n < 2; ++n) _Pragma("unroll") for (int k = 0; k < 2; ++k) dst[n][k] = *(const LAS bf16x8*)(lds + PG8_SB(b, h) + boff + n * 2048 + k * 1024); } while (0)
#define PG8_MMA(ai, bj, At, Bt) do { __builtin_amdgcn_s_setprio(1); _Pragma("unroll") for (int m = 0; m < 4; ++m) _Pragma("unroll") for (int n = 0; n < 2; ++n) _Pragma("unroll") for (int k = 0; k < 2; ++k) \
        acc[ai][bj][m][n] = __builtin_amdgcn_mfma_f32_16x16x32_bf16(Bt[n][k], At[m][k], acc[ai][bj][m][n], 0, 0, 0); __builtin_amdgcn_s_setprio(0); } while (0)
#define PG8_WAIT_V(n) asm volatile("s_waitcnt vmcnt(" #n ")" ::: "memory")
#define PG8_WAIT_L(n) asm volatile("s_waitcnt lgkmcnt(" #n ")" ::: "memory")
#define PG8_BAR __builtin_amdgcn_s_barrier()
#define PG8_SCHED __builtin_amdgcn_sched_barrier(0)
    Unit cur, nxt; int ui = 0;
    if (!S.next(0, cur)) return;
    f32x4 acc[2][2][4][2];
#pragma unroll
    for (int a = 0; a < 2; ++a)
#pragma unroll
        for (int b = 0; b < 2; ++b)
#pragma unroll
            for (int m = 0; m < 4; ++m)
#pragma unroll
                for (int n = 0; n < 2; ++n) acc[a][b][m][n] = (f32x4){0.f, 0.f, 0.f, 0.f};
    bf16x8 At[4][2], B0[2][2], B1[2][2];
    const char* cA = (const char*)g.A + (size_t)cur.pm * tstep + (size_t)cur.k0 * kstep; const char* cB = (const char*)g.Bt + (size_t)cur.pn * tstep + (size_t)cur.k0 * kstep;
    S.a_ready(cur);
    if constexpr (SP2) {
        PG8_STAGE(PG8_SB(0, 0), cB, voffB); PG8_STAGE(PG8_SB(0, 1), cB + hstep, voffB); PG8_STAGE(PG8_SA(0, 0), cA, voffA); PG8_STAGE(PG8_SA(0, 1), cA + hstep, voffA);
        if (wr == 1) PG8_BAR;
        PG8_WAIT_V(2); PG8_BAR;
        PG8_STAGE(PG8_SB(1, 0), cB + kstep, voffB); PG8_STAGE(PG8_SA(1, 0), cA + kstep, voffA); PG8_STAGE(PG8_SB(1, 1), cB + hstep + kstep, voffB);
        PG8_WAIT_V(6); PG8_BAR;
    } else {
        PG8_STAGE(PG8_SB(0, 0), cB, voffB); PG8_STAGE(PG8_SA(0, 0), cA, voffA); PG8_STAGE(PG8_SB(0, 1), cB + hstep, voffB); PG8_STAGE(PG8_SA(0, 1), cA + hstep, voffA);
        if (wr == 1) PG8_BAR;
        PG8_WAIT_V(4); PG8_BAR;
        PG8_STAGE(PG8_SB(1, 0), cB + kstep, voffB); PG8_STAGE(PG8_SA(1, 0), cA + kstep, voffA); PG8_STAGE(PG8_SB(1, 1), cB + hstep + kstep, voffB);
        PG8_WAIT_V(6); PG8_BAR;
    }
    for (;;) {
        const bool has_next = S.next(ui + 1, nxt);
        const char* nA = has_next ? (const char*)g.A + (size_t)nxt.pm * tstep + (size_t)nxt.k0 * kstep : cA; const char* nB = has_next ? (const char*)g.Bt + (size_t)nxt.pn * tstep + (size_t)nxt.k0 * kstep : cB;
        const int nt = cur.nt;
        for (int t = 0; t < nt; t += 2) {
            const bool last = (t == nt - 2);
            const char* a1 = cA + (size_t)(t + 1) * kstep;
            const char* a2 = last ? nA : cA + (size_t)(t + 2) * kstep; const char* b2 = last ? nB : cB + (size_t)(t + 2) * kstep;
            const char* a3 = a2 + kstep; const char* b3 = b2 + kstep;
            if (last && has_next) S.a_ready(nxt);
            if constexpr (SP2) {
            PG8_LDB(B0, 0, 0); PG8_LDB(B1, 0, 1); PG8_SCHED; PG8_LDA(At, 0, 0); PG8_STAGE(PG8_SA(1, 1), a1 + hstep, voffA);
            PG8_WAIT_V(8); PG8_WAIT_L(0); PG8_BAR; PG8_MMA(0, 0, At, B0); PG8_MMA(0, 1, At, B1); PG8_BAR; PG8_SCHED;
            PG8_LDA(At, 0, 1); PG8_STAGE(PG8_SB(0, 0), b2, voffB); PG8_STAGE(PG8_SB(0, 1), b2 + hstep, voffB); PG8_STAGE(PG8_SA(0, 0), a2, voffA);
            PG8_WAIT_V(8); PG8_WAIT_L(0); PG8_BAR; PG8_MMA(1, 0, At, B0); PG8_MMA(1, 1, At, B1); PG8_BAR; PG8_SCHED;
            PG8_LDB(B0, 1, 0); PG8_LDB(B1, 1, 1); PG8_SCHED; PG8_LDA(At, 1, 0); PG8_STAGE(PG8_SA(0, 1), a2 + hstep, voffA);
            PG8_WAIT_V(8); PG8_WAIT_L(0); PG8_BAR; PG8_MMA(0, 0, At, B0); PG8_MMA(0, 1, At, B1); PG8_BAR; PG8_SCHED;
            PG8_LDA(At, 1, 1); PG8_STAGE(PG8_SB(1, 0), b3, voffB); PG8_STAGE(PG8_SB(1, 1), b3 + hstep, voffB); PG8_STAGE(PG8_SA(1, 0), a3, voffA);
            PG8_WAIT_V(8); PG8_WAIT_L(0); PG8_BAR; PG8_MMA(1, 0, At, B0); PG8_MMA(1, 1, At, B1); PG8_BAR; PG8_SCHED;
            } else {
            PG8_LDB(B0, 0, 0); PG8_SCHED; PG8_LDA(At, 0, 0); PG8_STAGE(PG8_SA(1, 1), a1 + hstep, voffA);
            PG8_WAIT_L(8); PG8_BAR; PG8_WAIT_L(0); PG8_MMA(0, 0, At, B0); PG8_BAR; PG8_SCHED;
            PG8_LDB(B1, 0, 1); PG8_STAGE(PG8_SB(0, 0), b2, voffB);
            PG8_BAR; PG8_WAIT_L(0); PG8_MMA(0, 1, At, B1); PG8_BAR;
            PG8_LDA(At, 0, 1); PG8_STAGE(PG8_SA(0, 0), a2, voffA);
            PG8_BAR; PG8_WAIT_L(0); PG8_MMA(1, 0, At, B0); PG8_BAR; PG8_SCHED;
            PG8_STAGE(PG8_SB(0, 1), b2 + hstep, voffB);
            PG8_WAIT_V(6); PG8_BAR; PG8_MMA(1, 1, At, B1); PG8_BAR;
            PG8_LDB(B0, 1, 0); PG8_SCHED; PG8_LDA(At, 1, 0); PG8_STAGE(PG8_SA(0, 1), a2 + hstep, voffA);
            PG8_WAIT_L(8); PG8_BAR; PG8_WAIT_L(0); PG8_MMA(0, 0, At, B0); PG8_BAR; PG8_SCHED;
            PG8_LDB(B1, 1, 1); PG8_STAGE(PG8_SB(1, 0), b3, voffB);
            PG8_BAR; PG8_WAIT_L(0); PG8_MMA(0, 1, At, B1); PG8_BAR;
            PG8_LDA(At, 1, 1); PG8_STAGE(PG8_SA(1, 0), a3, voffA);
            PG8_BAR; PG8_WAIT_L(0); PG8_MMA(1, 0, At, B0); PG8_BAR; PG8_SCHED;
            PG8_STAGE(PG8_SB(1, 1), b3 + hstep, voffB);
            PG8_WAIT_V(6); PG8_BAR; PG8_MMA(1, 1, At, B1); PG8_BAR;
            }
        }
        if constexpr (ALIGN_EPI) { if (wr == 0) PG8_BAR; }
        if constexpr (!Epi::AFTER_DRAIN) { E(acc, cur, wr, wc, fr, fq); S.done(cur); }
        if (!has_next) break;
#pragma unroll
        for (int a = 0; a < 2; ++a)
#pragma unroll
            for (int b = 0; b < 2; ++b)
#pragma unroll
                for (int m = 0; m < 4; ++m)
#pragma unroll
                    for (int n = 0; n < 2; ++n) acc[a][b][m][n] = (f32x4){0.f, 0.f, 0.f, 0.f};
        cur = nxt; cA = nA; cB = nB; ++ui;
        if constexpr (ALIGN_EPI) { if (wr == 1) PG8_BAR; }
    }
    PG8_WAIT_V(0);
    if constexpr (!ALIGN_EPI) { if (wr == 0) PG8_BAR; }
    PG8_BAR;
#undef PG8_SA
#undef PG8_SB
#undef PG8_STAGE
#undef PG8_LDA
#undef PG8_LDB
#undef PG8_MMA
#undef PG8_WAIT_V
#undef PG8_WAIT_L
#undef PG8_BAR
#undef PG8_SCHED
}
}

struct KArgs {
    const float *x_prompt, *x_sample, *st_C, *st_n, *st_m, *st_conv, *cache_k, *cache_v, *c_prompt, *c_sample, *w_ada, *b_ada, *g_norm,
                *w_up1, *w_dn1, *w_up2, *w_dn2, *w_in, *conv_w, *conv_b, *b_gates, *g_mlstm, *rel_tab, *w_out, *g_final;
    float* out; unsigned char* ws;
    int ph_lo, ph_hi;
};

DI void transpose_item(const float* W, int ldw, int src_col0, int k0, bf16_t* WT, int K, int dest_row0, LAS float* scr, int lane) {
#pragma unroll 8
    for (int i = 0; i < 32; ++i) { const int kk = 2 * i + (lane >> 5); scr[kk * 33 + (lane & 31)] = W[(size_t)(k0 + kk) * ldw + src_col0 + (lane & 31)]; }
    asm volatile("s_waitcnt lgkmcnt(0)" ::: "memory");
    const int c = lane & 7;
#pragma unroll
    for (int j = 0; j < 4; ++j) { const int n = (lane >> 3) + 8 * j; const LAS float* s = scr + (8 * c) * 33 + n;
        u32x4 o; o.x = cvt_pk_bf16(s[0 * 33], s[1 * 33]); o.y = cvt_pk_bf16(s[2 * 33], s[3 * 33]); o.z = cvt_pk_bf16(s[4 * 33], s[5 * 33]); o.w = cvt_pk_bf16(s[6 * 33], s[7 * 33]);
        *(u32x4*)(WT + (size_t)(dest_row0 + n) * K + k0 + 8 * c) = o; }
    asm volatile("s_waitcnt lgkmcnt(0)" ::: "memory");
}
DI void up_item(const float* W, bf16_t* WT, int it, LAS float* scr, int lane) {
    const int kb = it / 176, nb = it % 176, n0 = 32 * nb; const bool isu = n0 >= DFF; const int hid = isu ? n0 - DFF : n0;
    transpose_item(W, NUP, n0, 64 * kb, WT, DM, (hid >> 7) * 256 + (isu ? 128 : 0) + (hid & 127), scr, lane);
}
DI void convert_group(const KArgs& a, int grp, int widx, int nw, LAS unsigned char* lds, int wave, int lane) {
    LAS float* scr = (LAS float*)(lds + wave * 8448);
    constexpr int I_UP = 16 * 176, I_DN = 44 * 32, I_IN = 16 * 112, I_OUT = 16 * 32;
    if (grp == 0) {
        for (int r = widx; r < I_UP; r += nw) up_item(a.w_up1, (bf16_t*)(a.ws + WS_WUP1), r, scr, lane);
    } else if (grp == 1) {
        for (int r = widx; r < I_DN + I_IN + I_OUT; r += nw) {
            if (r < I_DN) transpose_item(a.w_dn1, DM, 32 * (r % 32), 64 * (r / 32), (bf16_t*)(a.ws + WS_WDN1), DFF, 32 * (r % 32), scr, lane);
            else if (r < I_DN + I_IN) { const int q = r - I_DN, n0 = 32 * (q % 112); transpose_item(a.w_in, DIN, n0 + (n0 >= 2048 ? 8 : 0), 64 * (q / 112), (bf16_t*)(a.ws + WS_WIN), DM, n0, scr, lane); }
            else { const int q = r - I_DN - I_IN; transpose_item(a.w_out, DM, 32 * (q % 32), 64 * (q / 32), (bf16_t*)(a.ws + WS_WOUT), DM, 32 * (q % 32), scr, lane); }
        }
    } else {
        const float* wu = grp == 0 ? a.w_up1 : a.w_up2; const float* wd = grp == 0 ? a.w_dn1 : a.w_dn2;
        bf16_t* du = (bf16_t*)(a.ws + (grp == 0 ? WS_WUP1 : WS_WUP2)); bf16_t* dd = (bf16_t*)(a.ws + (grp == 0 ? WS_WDN1 : WS_WDN2));
        for (int r = widx; r < I_UP + I_DN; r += nw) {
            if (r < I_UP) up_item(wu, du, r, scr, lane);
            else { const int q = r - I_UP; transpose_item(wd, DM, 32 * (q % 32), 64 * (q / 32), dd, DFF, 32 * (q % 32), scr, lane); }
        }
    }
}
DI void kvc_convert(const KArgs& a, int T, int NT) {
    bf16_t* KVC = (bf16_t*)(a.ws + WS_CST);
    for (int pc = T; pc < 32 * 512 * 128; pc += NT) {
        const int row = pc >> 7, q = pc & 127;
        const f32x4* src = (const f32x4*)((q < 64 ? a.cache_k : a.cache_v) + (size_t)row * 512 + (q & 63) * 8);
        const f32x4 v0 = src[0], v1 = src[1];
        u32x4 w; w.x = cvt_pk_bf16(v0[0], v0[1]); w.y = cvt_pk_bf16(v0[2], v0[3]); w.z = cvt_pk_bf16(v1[0], v1[1]); w.w = cvt_pk_bf16(v1[2], v1[3]);
        *(u32x4*)(KVC + (size_t)row * 1024 + q * 8) = w;
    }
}
DI void phase_prologue(const KArgs& a, LAS unsigned char* lds, int tid, int wave, int lane) {
    float* mod = (float*)(a.ws + WS_MOD);
    for (int cgi = blockIdx.x; cgi < NMOD / 64; cgi += gridDim.x) {
        LAS float* cs = (LAS float*)lds;
        for (int i = tid; i < 34 * 1024; i += 512) { const int r = i >> 10, k = i & 1023; const float c = r < 2 ? a.c_prompt[r * 1024 + k] : a.c_sample[(r - 2) * 1024 + k]; cs[i] = siluf_(c); }
        __syncthreads();
        float acc[34];
#pragma unroll
        for (int r = 0; r < 34; ++r) acc[r] = 0.f;
        const int col = cgi * 64 + lane;
        const float* wp = a.w_ada + (size_t)(wave * 128) * NMOD + col;
#define ADA_LD(dst, k4) do { const int kc_ = (k4) < 128 ? (k4) : 124; _Pragma("unroll") for (int i = 0; i < 4; ++i) dst[i] = wp[(size_t)(kc_ + i) * NMOD]; } while (0)
        float wa[4], wb[4], wc[4], wd[4];
        ADA_LD(wa, 0); ADA_LD(wb, 4); ADA_LD(wc, 8); ADA_LD(wd, 12);
        for (int kk = 0; kk < 128; kk += 4) {
            const int k = wave * 128 + kk;
            float w[4];
#pragma unroll
            for (int i = 0; i < 4; ++i) { w[i] = wa[i]; wa[i] = wb[i]; wb[i] = wc[i]; wc[i] = wd[i]; }
            ADA_LD(wd, kk + 16);
#pragma unroll
            for (int r = 0; r < 34; ++r) { const f32x4 c4 = *(const LAS f32x4*)(cs + r * 1024 + k); acc[r] += c4[0] * w[0] + c4[1] * w[1] + c4[2] * w[2] + c4[3] * w[3]; }
        }
#undef ADA_LD
        __syncthreads();
        LAS float* part = (LAS float*)lds;
#pragma unroll
        for (int r = 0; r < 34; ++r) part[(wave * 34 + r) * 64 + lane] = acc[r];
        __syncthreads();
        for (int o = tid; o < 34 * 64; o += 512) { const int r = o >> 6, l = o & 63; float s = a.b_ada[cgi * 64 + l];
#pragma unroll
            for (int w = 0; w < 8; ++w) s += part[(w * 34 + r) * 64 + l];
            mod[(size_t)r * NMOD + cgi * 64 + l] = s; }
        __syncthreads();
    }
    {
        bf16_t* PREVB = (bf16_t*)(a.ws + WS_PREVB);
        const int T = blockIdx.x * 512 + tid, NT = gridDim.x * 512;
        for (int i = T; i < 34 * 3 * 512; i += NT) {
            const int e = i * 2;
            unsigned w = 0u;
            if (e >= 2 * 3 * 1024) { const float* p = a.st_conv + (e - 2 * 3 * 1024); w = cvt_pk_bf16(p[0], p[1]); }
            *(unsigned*)(PREVB + e) = w;
        }
    }
    convert_group(a, 0, blockIdx.x * 8 + wave, gridDim.x * 8, lds, wave, lane);
}

template <bool GATES, int NSPLIT, bool P16>
DI void phase_norm(const KArgs& a, const float* xp, const bf16_t* xp16, const float* xs, float* xsw, const float* g, int shift_off, int scale_off, int pgate_off, float pcoef, int row_begin, LAS unsigned char* lds, int tid, int wave, int lane) {
    const float* mod = (const float*)(a.ws + WS_MOD);
    bf16_t* HN = (bf16_t*)(a.ws + WS_HN);
    float* gates = (float*)(a.ws + WS_GATES);
    f32x4 wgr[8][4];
    if (GATES) {
#pragma unroll
        for (int j = 0; j < 4; ++j)
#pragma unroll
            for (int i = 0; i < 4; ++i) {
                const f32x4* p = (const f32x4*)(a.w_in + (size_t)(4 * lane + 256 * j + i) * DIN + 2048);
                const f32x4 lo = p[0], hi = p[1];
                wgr[0][j][i] = lo[0]; wgr[1][j][i] = lo[1]; wgr[2][j][i] = lo[2]; wgr[3][j][i] = lo[3]; wgr[4][j][i] = hi[0]; wgr[5][j][i] = hi[1]; wgr[6][j][i] = hi[2]; wgr[7][j][i] = hi[3];
            }
    }
    const int gw = blockIdx.x * 8 + wave, NGW = gridDim.x * 8;
    for (int row = row_begin + gw; row < M; row += NGW) {
        f32x4 v[4]; float ss = 0.f;
        if (P16 && row < MP) {
            const u32x2* xr = (const u32x2*)(xp16 + (size_t)row * DM) + lane;
#pragma unroll
            for (int j = 0; j < 4; ++j) { const u32x2 w = xr[64 * j]; v[j] = (f32x4){bflo(w.x), bfhi(w.x), bflo(w.y), bfhi(w.y)}; }
        } else {
            const f32x4* xr = (const f32x4*)(row < MP ? xp + (size_t)row * DM : xs + (size_t)(row - MP) * DM) + lane;
#pragma unroll
            for (int j = 0; j < 4; ++j) v[j] = xr[64 * j];
        }
        const float* md = mod + (size_t)modrow(row) * NMOD;
        if (NSPLIT > 0 && row >= MP) {
            const float* part = (const float*)(a.ws + WS_UT) + (size_t)(row - MP) * DM;
#pragma unroll
            for (int j = 0; j < 4; ++j) {
                const int col = 4 * lane + 256 * j;
                f32x4 sum = *(const f32x4*)(part + col);
#pragma unroll
                for (int sp = 1; sp < NSPLIT; ++sp) sum += *(const f32x4*)(part + (size_t)sp * MS * DM + col);
                v[j] += (*(const f32x4*)(md + pgate_off + col) * pcoef) * sum;
                *(f32x4*)(xsw + (size_t)(row - MP) * DM + col) = v[j];
            }
        }
#pragma unroll
        for (int j = 0; j < 4; ++j) ss += (v[j][0] * v[j][0] + v[j][1] * v[j][1]) + (v[j][2] * v[j][2] + v[j][3] * v[j][3]);
        const float rstd = 1.0f / sqrtf(wave_sum(ss) * (1.0f / DM) + EPS);
        float gp[8];
#pragma unroll
        for (int c = 0; c < 8; ++c) gp[c] = 0.f;
#pragma unroll
        for (int j = 0; j < 4; ++j) {
            const int col = 4 * lane + 256 * j;
            const f32x4 g4 = *(const f32x4*)(g + col), sc = *(const f32x4*)(md + scale_off + col), sh = *(const f32x4*)(md + shift_off + col);
            const f32x4 h = (v[j] * rstd * g4) * (sc + 1.0f) + sh;
            u32x2 w; w.x = cvt_pk_bf16(h[0], h[1]); w.y = cvt_pk_bf16(h[2], h[3]);
            *(u32x2*)(HN + (size_t)row * DM + col) = w;
            if (GATES) {
#pragma unroll
                for (int c = 0; c < 8; ++c) { const f32x4 w4 = wgr[c][j]; gp[c] += (h[0] * w4[0] + h[1] * w4[1]) + (h[2] * w4[2] + h[3] * w4[3]); }
            }
        }
        if (GATES) {
            const bool b5 = (lane & 32) != 0, b4 = (lane & 16) != 0, b3 = (lane & 8) != 0;
            float k4[4], k2[2], k1;
#pragma unroll
            for (int i = 0; i < 4; ++i) { const float snd = b5 ? gp[i] : gp[i + 4]; k4[i] = (b5 ? gp[i + 4] : gp[i]) + __shfl_xor(snd, 32); }
#pragma unroll
            for (int i = 0; i < 2; ++i) { const float snd = b4 ? k4[i] : k4[i + 2]; k2[i] = (b4 ? k4[i + 2] : k4[i]) + __shfl_xor(snd, 16); }
            { const float snd = b3 ? k2[0] : k2[1]; k1 = (b3 ? k2[1] : k2[0]) + __shfl_xor(snd, 8); }
            k1 += __shfl_xor(k1, 4); k1 += __shfl_xor(k1, 2); k1 += __shfl_xor(k1, 1);
            const int c = (b5 ? 4 : 0) + (b4 ? 2 : 0) + (b3 ? 1 : 0);
            if ((lane & 7) == 0) gates[(size_t)row * 8 + c] = k1 + a.b_gates[c];
        }
    }
}
DI void phase_final_norm(const KArgs& a, const bf16_t* x16, const float* xs, int row_begin, int wave, int lane) {
    const int gw = blockIdx.x * 8 + wave, NGW = gridDim.x * 8;
    const float* mod = (const float*)(a.ws + WS_MOD);
    for (int row = row_begin + gw; row < M; row += NGW) {
        f32x4 v[4]; float ss = 0.f;
        if (row < MP) {
            const u32x2* xr = (const u32x2*)(x16 + (size_t)row * DM) + lane;
#pragma unroll
            for (int j = 0; j < 4; ++j) { const u32x2 w = xr[64 * j]; v[j] = (f32x4){bflo(w.x), bfhi(w.x), bflo(w.y), bfhi(w.y)}; }
        } else {
            const float* part = (const float*)(a.ws + WS_UT) + (size_t)(row - MP) * DM;
            const float* md = mod + (size_t)modrow(row) * NMOD + 8 * DM;
#pragma unroll
            for (int j = 0; j < 4; ++j) {
                const int col = 4 * lane + 256 * j;
                f32x4 sum = *(const f32x4*)(part + col);
#pragma unroll
                for (int sp = 1; sp < 4; ++sp) sum += *(const f32x4*)(part + (size_t)sp * MS * DM + col);
                v[j] = *(const f32x4*)(xs + (size_t)(row - MP) * DM + col) + (*(const f32x4*)(md + col) * 0.5f) * sum;
            }
        }
#pragma unroll
        for (int j = 0; j < 4; ++j) ss += (v[j][0] * v[j][0] + v[j][1] * v[j][1]) + (v[j][2] * v[j][2] + v[j][3] * v[j][3]);
        const float rstd = 1.0f / sqrtf(wave_sum(ss) * (1.0f / DM) + EPS);
        f32x4* yr = (f32x4*)(a.out + (size_t)row * DM) + lane;
#pragma unroll
        for (int j = 0; j < 4; ++j) { const f32x4 g4 = *(const f32x4*)(a.g_final + 4 * lane + 256 * j); yr[64 * j] = v[j] * rstd * g4; }
    }
}

constexpr int TP = 72;
DI void conv_load(const KArgs& a, const bf16_t* PROJ, int gc, int s0, int cch, unsigned (&u)[11]) {
    const int row0 = gc * 64;
    const bool special = gc >= 512 || (gc & 255) == 0;
    const bf16_t* PREVB = (const bf16_t*)(a.ws + WS_PREVB) + (size_t)(gc < 512 ? (gc >> 8) : 2 + (gc - 512)) * 3 * 1024;
#pragma unroll
    for (int r = 0; r < 11; ++r) {
        const int tp = s0 - 3 + r;
        const bf16_t* p = (tp < 0 && special) ? PREVB + (3 + tp) * 1024 + cch : PROJ + (size_t)(row0 + tp) * NPROJ + cch;
        u[r] = *(const unsigned*)p;
    }
}
typedef float f32x2v __attribute__((ext_vector_type(2)));
struct ConvW { f32x2v w[4]; f32x2v b; };
DI void convw_load(const KArgs& a, int cch, ConvW& W) {
#pragma unroll
    for (int j = 0; j < 4; ++j) W.w[j] = *(const f32x2v*)(a.conv_w + j * 1024 + cch);
    W.b = *(const f32x2v*)(a.conv_b + cch);
}
DI void conv_math(const ConvW& W, const unsigned (&u)[11], float (&o0)[8], float (&o1)[8]) {
#pragma unroll
    for (int j = 0; j < 8; ++j) {
        float x0 = W.b[0], x1 = W.b[1];
#pragma unroll
        for (int tap = 0; tap < 4; ++tap) { x0 += W.w[tap][0] * bflo(u[j + tap]); x1 += W.w[tap][1] * bfhi(u[j + tap]); }
        o0[j] = siluf_(x0); o1[j] = siluf_(x1);
    }
}
DI u32x4 pack8f(const float (&v)[8]) { u32x4 w; w.x = cvt_pk_bf16(v[0], v[1]); w.y = cvt_pk_bf16(v[2], v[3]); w.z = cvt_pk_bf16(v[4], v[5]); w.w = cvt_pk_bf16(v[6], v[7]); return w; }
DI void store_vT(const unsigned (&v)[8], int s0, LAS bf16_t* VT, int ch, int sw) {
    u32x4 lo, hi;
    lo.x = (v[0] & 0xffffu) | (v[1] << 16); lo.y = (v[2] & 0xffffu) | (v[3] << 16); lo.z = (v[4] & 0xffffu) | (v[5] << 16); lo.w = (v[6] & 0xffffu) | (v[7] << 16);
    hi.x = (v[0] >> 16) | (v[1] & 0xffff0000u); hi.y = (v[2] >> 16) | (v[3] & 0xffff0000u); hi.z = (v[4] >> 16) | (v[5] & 0xffff0000u); hi.w = (v[6] >> 16) | (v[7] & 0xffff0000u);
    *(LAS u32x4*)(VT + ch * TP + (s0 ^ sw)) = lo; *(LAS u32x4*)(VT + (ch + 1) * TP + (s0 ^ sw)) = hi;
}
DI float gate_cumsum(float fg, int lane) {
    float lf = fminf(fg, 0.f) - 0.6931471805599453f * __builtin_amdgcn_logf(1.0f + fexp(-fabsf(fg)));
#pragma unroll
    for (int o = 1; o < 64; o <<= 1) { const float t = __shfl_up(lf, o); if (lane >= o) lf += t; }
    return lf;
}
DI void store16_bf16(LAS bf16_t* p, const float (&o)[16]) {
    u32x4 w0, w1;
    w0.x = cvt_pk_bf16(o[0], o[1]); w0.y = cvt_pk_bf16(o[2], o[3]); w0.z = cvt_pk_bf16(o[4], o[5]); w0.w = cvt_pk_bf16(o[6], o[7]);
    w1.x = cvt_pk_bf16(o[8], o[9]); w1.y = cvt_pk_bf16(o[10], o[11]); w1.z = cvt_pk_bf16(o[12], o[13]); w1.w = cvt_pk_bf16(o[14], o[15]);
    *(LAS u32x4*)p = w0; *(LAS u32x4*)(p + 8) = w1;
}

struct ALoad { unsigned uk[11], v[8]; float fg, ig; };
DI void a_issue(const KArgs& a, int gc, int h, int wave, int lane, ALoad& L) {
    const bf16_t* PROJ = (const bf16_t*)(a.ws + WS_PROJ);
    const float* gates = (const float*)(a.ws + WS_GATES);
    const int row0 = gc * 64, s0 = 8 * wave, ch = 2 * lane;
    conv_load(a, PROJ, gc, s0, PK + h * 128 + ch, L.uk);
#pragma unroll
    for (int j = 0; j < 8; ++j) L.v[j] = *(const unsigned*)(PROJ + (size_t)(row0 + s0 + j) * NPROJ + PV + h * 128 + ch);
    L.fg = gates[(size_t)(row0 + lane) * 8 + 4 + h]; L.ig = gates[(size_t)(row0 + lane) * 8 + h];
}
DI void mlstmA_loop(const KArgs& a, LAS unsigned char* lds, int jbeg, int jend, int tid, int wave, int lane) {
    float* chk = (float*)(a.ws + WS_CHK);
    bf16_t* UT = (bf16_t*)(a.ws + WS_UT);
    const int fr = lane & 15, g = lane >> 4;
    int j = jbeg;
    if (j >= jend) return;
#define A_GC(jx) ((((jx) % NGC) * 33) % NGC)
    ALoad L; a_issue(a, A_GC(j), j / NGC, wave, lane, L);
    ConvW Wk; int hw = j / NGC; convw_load(a, PK + hw * 128 + 2 * lane, Wk);
    for (; j < jend; ++j) {
        const int gc = A_GC(j), h = j / NGC, idx = gc * 4 + h;
        LAS bf16_t* KgT = (LAS bf16_t*)(lds + ((j - jbeg) & 1) * (2 * 128 * TP * 2));
        LAS bf16_t* VT = KgT + 128 * TP;
        if (h != hw) { hw = h; convw_load(a, PK + hw * 128 + 2 * lane, Wk); }
        const float b = gate_cumsum(L.fg, lane);
        const float bend = __shfl(b, 63);
        const float logg = bend - b + L.ig;
        const float mloc = wave_max(logg);
        const float gv = fexp(logg - mloc);
        if (tid == 0) { chk[idx] = bend; chk[NGC * 4 + idx] = mloc; }
        {
            const int s0 = 8 * wave, ch = 2 * lane, sw = 8 * (ch >> 4);
            float k0[8], k1[8]; conv_math(Wk, L.uk, k0, k1);
#pragma unroll
            for (int j = 0; j < 8; ++j) { const float gs = __shfl(gv, s0 + j) * 0.08838834764831845f; k0[j] *= gs; k1[j] *= gs; }
            *(LAS u32x4*)(KgT + ch * TP + (s0 ^ sw)) = pack8f(k0); *(LAS u32x4*)(KgT + (ch + 1) * TP + (s0 ^ sw)) = pack8f(k1);
            store_vT(L.v, s0, VT, ch, sw);
        }
        __syncthreads();
        { const int jn = j + 1 < jend ? j + 1 : j; a_issue(a, A_GC(jn), jn / NGC, wave, lane, L); }
        bf16x8 aF[2];
#pragma unroll
        for (int ks = 0; ks < 2; ++ks) aF[ks] = *(const LAS bf16x8*)(KgT + (16 * wave + fr) * TP + ((32 * ks + 8 * g) ^ (8 * wave)));
        bf16_t* ub = UT + (size_t)idx * 129 * 128 + 16 * wave + 4 * g;
        const bool smp = gc >= 512; const int sh = (gc - 512) * 4 + h, dk0 = 16 * wave + 4 * g;
        float dec = 0.f, scl = 0.f;
        bf16_t* cb = (bf16_t*)(a.ws + WS_CST) + (size_t)idx * 129 * 128 + dk0;
        if (smp) {
            const float m_in = a.st_m[sh], mn = fmaxf(bend + m_in, mloc);
            dec = fexp(bend + m_in - mn); scl = fexp(mloc - mn);
            if (tid == 0) { chk[2 * NGC * 4 + idx] = m_in; a.out[OFF_M_S + sh] = mn; }
        }
#pragma unroll
        for (int jt = 0; jt < 8; ++jt) {
            f32x4 acc = {0.f, 0.f, 0.f, 0.f};
#pragma unroll
            for (int ks = 0; ks < 2; ++ks) { const bf16x8 bF = *(const LAS bf16x8*)(VT + (16 * jt + fr) * TP + ((32 * ks + 8 * g) ^ (8 * jt))); acc = MFMA16(aF[ks], bF, acc); }
            if (!smp) {
                u32x2 w; w.x = cvt_pk_bf16(acc[0], acc[1]); w.y = cvt_pk_bf16(acc[2], acc[3]);
                *(u32x2*)(ub + (size_t)(16 * jt + fr) * 128) = w;
            } else {
                const size_t eo = ((size_t)sh * 128 + dk0) * 128 + 16 * jt + fr;
                const float* ci = a.st_C + eo; float* co = a.out + OFF_C_S + eo;
                const float c0 = ci[0], c1 = ci[128], c2 = ci[256], c3 = ci[384];
                co[0] = dec * c0 + scl * acc[0]; co[128] = dec * c1 + scl * acc[1]; co[256] = dec * c2 + scl * acc[2]; co[384] = dec * c3 + scl * acc[3];
                u32x2 w; w.x = cvt_pk_bf16(c0, c1); w.y = cvt_pk_bf16(c2, c3);
                *(u32x2*)(cb + (size_t)(16 * jt + fr) * 128) = w;
            }
        }
        {
            const short one = fr == 0 ? (short)0x3F80 : (short)0;
            const bf16x8 bF = {one, one, one, one, one, one, one, one};
            f32x4 acc = {0.f, 0.f, 0.f, 0.f};
#pragma unroll
            for (int ks = 0; ks < 2; ++ks) acc = MFMA16(aF[ks], bF, acc);
            if (fr == 0) {
                if (!smp) { u32x2 w; w.x = cvt_pk_bf16(acc[0], acc[1]); w.y = cvt_pk_bf16(acc[2], acc[3]); *(u32x2*)(ub + (size_t)128 * 128) = w; }
                else {
                    const f32x4 n4 = *(const f32x4*)(a.st_n + (size_t)sh * 128 + dk0);
                    *(f32x4*)(a.out + OFF_N_S + (size_t)sh * 128 + dk0) = n4 * dec + acc * scl;
                    u32x2 w; w.x = cvt_pk_bf16(n4[0], n4[1]); w.y = cvt_pk_bf16(n4[2], n4[3]); *(u32x2*)(cb + (size_t)128 * 128) = w;
                }
            }
        }
    }
    __syncthreads();
}

DI bf16x8 pack8(const f32x4 lo, const f32x4 hi) {
    u32x4 w; w.x = cvt_pk_bf16(lo[0], lo[1]); w.y = cvt_pk_bf16(lo[2], lo[3]); w.z = cvt_pk_bf16(hi[0], hi[1]); w.w = cvt_pk_bf16(hi[2], hi[3]);
    return __builtin_bit_cast(bf16x8, w);
}
constexpr int VP32 = 40;
constexpr int ATT_WAVE_LDS = 64 * 64 * 2 + 64 * VP32 * 2;
DI void attn_item(const KArgs& a, int gc, LAS unsigned char* lds, int wave, int lane) {
    const bf16_t* PROJ = (const bf16_t*)(a.ws + WS_PROJ);
    const bf16_t* KVC = (const bf16_t*)(a.ws + WS_CST);
    bf16_t* MIX = (bf16_t*)(a.ws + WS_HN);
    const int h = wave, fr = lane & 15, g = lane >> 4, row0 = gc * 64;
    const bool is_s = gc >= 512; const int sidx = gc - 512, c = gc & 255;
    LAS unsigned char* Qs = lds + wave * ATT_WAVE_LDS;
    LAS bf16_t* VT = (LAS bf16_t*)(lds + wave * ATT_WAVE_LDS + 8192);
    const LAS float* tab = (const LAS float*)(lds + TAB_OFF) + h * 256;
#pragma unroll
    for (int i8 = 0; i8 < 8; ++i8) {
        const int t = (lane >> 3) + 8 * i8, cq = lane & 7;
        const u32x4 w = *(const u32x4*)(PROJ + (size_t)(row0 + t) * NPROJ + PAQ + 64 * h + 8 * cq);
        *(LAS u32x4*)(Qs + t * 128 + ((cq ^ (t & 7)) << 4)) = w;
    }
    float mrun[4], lrun[4]; f32x4 oacc[4][4];
#pragma unroll
    for (int tt = 0; tt < 4; ++tt) { mrun[tt] = -INFINITY; lrun[tt] = 0.f;
#pragma unroll
        for (int dt = 0; dt < 4; ++dt) oacc[dt][tt] = (f32x4){0.f, 0.f, 0.f, 0.f}; }
    const int kt0 = is_s ? 0 : (c >= 8 ? 0 : 8 - c);
#define ATT_SRC(j2_, kp_, vp_, pitch_) do { const int kt_ = (j2_) >> 1, hf_ = (j2_) & 1; if (is_s && kt_ < 8) { kp_ = KVC + (size_t)(sidx * 512 + 64 * kt_ + 32 * hf_) * 1024 + 64 * h; vp_ = kp_ + 512; pitch_ = 1024; } \
        else { const size_t kr_ = (size_t)(row0 - (8 - kt_) * 64 + 32 * hf_); kp_ = PROJ + kr_ * NPROJ + PAK + 64 * h; vp_ = PROJ + kr_ * NPROJ + PAV + 64 * h; pitch_ = NPROJ; } } while (0)
#define ATT_LOAD(KF, VR, kp_, vp_, pitch_) do { const unsigned koff_ = (unsigned)(fr * (pitch_) + 8 * g) * 2u, voff_ = (unsigned)((lane >> 3) * (pitch_) + 8 * (lane & 7)) * 2u; \
        _Pragma("unroll") for (int it = 0; it < 2; ++it) _Pragma("unroll") for (int ks = 0; ks < 2; ++ks) KF[it][ks] = *(const bf16x8*)((const char*)(kp_ + (size_t)(16 * it) * (pitch_) + 32 * ks) + koff_); \
        _Pragma("unroll") for (int jj = 0; jj < 4; ++jj) VR[jj] = *(const u32x4*)((const char*)(vp_ + (size_t)(8 * jj) * (pitch_)) + voff_); } while (0)
    bf16x8 kf[2][2]; u32x4 vr[4];
    { const bf16_t* kp; const bf16_t* vp; int pitch; ATT_SRC(2 * kt0, kp, vp, pitch); ATT_LOAD(kf, vr, kp, vp, pitch); }
    const float bias_far = tab[191];
    for (int j2 = 2 * kt0; j2 < 18; ++j2) {
#pragma unroll
        for (int jj = 0; jj < 4; ++jj) {
            const int key = (lane >> 3) + 8 * jj, p = lane & 7, ksw = key ^ (8 * (p & 3));
            const unsigned ww[4] = {vr[jj].x, vr[jj].y, vr[jj].z, vr[jj].w};
#pragma unroll
            for (int e = 0; e < 4; ++e) { VT[(8 * p + 2 * e) * VP32 + ksw] = (bf16_t)(ww[e] & 0xffffu); VT[(8 * p + 2 * e + 1) * VP32 + ksw] = (bf16_t)(ww[e] >> 16); }
        }
        bf16x8 kn[2][2];
        { const int jn = j2 < 17 ? j2 + 1 : j2; const bf16_t* kp; const bf16_t* vp; int pitch; ATT_SRC(jn, kp, vp, pitch); ATT_LOAD(kn, vr, kp, vp, pitch); }
        const int kt = j2 >> 1;
        const int relb = 64 * (8 - kt) - 32 * (j2 & 1);
        const LAS float* tb = tab + (fr - 4 * g + relb + 63 - 64);
        bf16x8 vA[4];
#pragma unroll
        for (int dt = 0; dt < 4; ++dt) {
            const int sw = 8 * ((2 * dt + (fr >> 3)) & 3);
            const LAS bf16_t* vrow = VT + (16 * dt + fr) * VP32;
            const s16x4 lo = *(const LAS s16x4*)(vrow + ((4 * g) ^ sw)), hi = *(const LAS s16x4*)(vrow + ((16 + 4 * g) ^ sw));
            vA[dt] = __builtin_shufflevector(lo, hi, 0, 1, 2, 3, 4, 5, 6, 7);
        }
        f32x4 sacc[4][2];
#pragma unroll
        for (int tt = 0; tt < 4; ++tt) {
            const int t = 16 * tt + fr;
            bf16x8 qB[2];
#pragma unroll
            for (int ks = 0; ks < 2; ++ks) qB[ks] = *(const LAS bf16x8*)(Qs + t * 128 + (((4 * ks + g) ^ (t & 7)) << 4));
#pragma unroll
            for (int it = 0; it < 2; ++it) { sacc[tt][it] = (f32x4){0.f, 0.f, 0.f, 0.f};
#pragma unroll
                for (int ks = 0; ks < 2; ++ks) sacc[tt][it] = MFMA16(kf[it][ks], qB[ks], sacc[tt][it]); }
        }
        if (kt <= 5) {
#pragma unroll
            for (int tt = 0; tt < 4; ++tt)
#pragma unroll
                for (int it = 0; it < 2; ++it)
#pragma unroll
                    for (int r = 0; r < 4; ++r) sacc[tt][it][r] = __builtin_fmaf(sacc[tt][it][r], 0.125f * LOG2E, bias_far);
        } else {
#pragma unroll
            for (int tt = 0; tt < 4; ++tt)
#pragma unroll
                for (int it = 0; it < 2; ++it)
#pragma unroll
                    for (int r = 0; r < 4; ++r) sacc[tt][it][r] = __builtin_fmaf(sacc[tt][it][r], 0.125f * LOG2E, tb[16 * (tt - it) - r + 64]);
        }
        float tmax[4]; bool need = false;
#pragma unroll
        for (int tt = 0; tt < 4; ++tt) {
            float m = __builtin_fmaxf(__builtin_fmaxf(sacc[tt][0][0], sacc[tt][0][1]), sacc[tt][0][2]);
            m = __builtin_fmaxf(__builtin_fmaxf(m, sacc[tt][0][3]), sacc[tt][1][0]);
            m = __builtin_fmaxf(__builtin_fmaxf(m, sacc[tt][1][1]), sacc[tt][1][2]);
            tmax[tt] = __builtin_fmaxf(m, sacc[tt][1][3]);
            need = need || (tmax[tt] > mrun[tt] + 8.0f);
        }
        if (__any(need)) {
#pragma unroll
            for (int tt = 0; tt < 4; ++tt) {
                float m = tmax[tt]; m = __builtin_fmaxf(m, __shfl_xor(m, 16)); m = __builtin_fmaxf(m, __shfl_xor(m, 32));
                const float mnew = __builtin_fmaxf(mrun[tt], m);
                const float alpha = fexp2(mrun[tt] - mnew); lrun[tt] *= alpha; mrun[tt] = mnew;
#pragma unroll
                for (int dt = 0; dt < 4; ++dt) oacc[dt][tt] = oacc[dt][tt] * alpha;
            }
        }
#pragma unroll
        for (int tt = 0; tt < 4; ++tt) {
            const float mref = mrun[tt];
            float lsum = 0.f;
#pragma unroll
            for (int it = 0; it < 2; ++it)
#pragma unroll
                for (int r = 0; r < 4; ++r) { const float p = fexp2(sacc[tt][it][r] - mref); sacc[tt][it][r] = p; lsum += p; }
            lrun[tt] += lsum;
            const bf16x8 pB = pack8(sacc[tt][0], sacc[tt][1]);
#pragma unroll
            for (int dt = 0; dt < 4; ++dt) oacc[dt][tt] = MFMA16(vA[dt], pB, oacc[dt][tt]);
        }
#pragma unroll
        for (int it = 0; it < 2; ++it)
#pragma unroll
            for (int ks = 0; ks < 2; ++ks) kf[it][ks] = kn[it][ks];
    }
#undef ATT_SRC
#undef ATT_LOAD
#pragma unroll
    for (int tt = 0; tt < 4; ++tt) {
        float l = lrun[tt]; l += __shfl_xor(l, 16); l += __shfl_xor(l, 32);
        const float inv = 1.0f / l;
#pragma unroll
        for (int dt = 0; dt < 4; ++dt) {
            const f32x4 o = oacc[dt][tt] * inv;
            u32x2 w; w.x = cvt_pk_bf16(o[0], o[1]); w.y = cvt_pk_bf16(o[2], o[3]);
            *(u32x2*)(MIX + (size_t)(row0 + 16 * tt + fr) * DM + 512 + 64 * h + 16 * dt + 4 * g) = w;
        }
    }
}
#ifndef ATT_N7
#define ATT_N7 191
#endif
DI void phase_mixA(const KArgs& a, LAS unsigned char* lds, int tid, int wave, int lane) {
    LAS float* tab = (LAS float*)(lds + TAB_OFF);
    for (int i = tid; i < 8 * 256; i += 512) { const int e = i & 255; tab[i] = a.rel_tab[(i >> 8) * 192 + (e > 191 ? 191 : e)] * LOG2E; }
    __syncthreads();
    for (int it = ATT_N7 + blockIdx.x; it < NGC; it += gridDim.x) attn_item(a, it, lds, wave, lane);
    __syncthreads();
    int jbeg, jend; const int b = (int)blockIdx.x, Gd = (int)gridDim.x;
    if (Gd == 256 && ATT_N7 == 191) {
        const int n2 = (NGC - ATT_N7) - 256;
        constexpr int NLO = 4, NHI = 11; const int extra = NGC * 4 - (n2 * NLO + (256 - n2) * NHI);
        if (b < n2) { jbeg = NLO * b; jend = jbeg + NLO; }
        else { const int q = b - n2; jbeg = n2 * NLO + q * NHI + (q < extra ? q : extra); jend = jbeg + NHI + (q < extra ? 1 : 0); }
    } else { const int per = (NGC * 4 + Gd - 1) / Gd; jbeg = b * per; jend = jbeg + per < NGC * 4 ? jbeg + per : NGC * 4; }
    mlstmA_loop(a, lds, jbeg, jend, tid, wave, lane);
}

DI void phase_scan(const KArgs& a, int tid) {
    const bf16_t* UT = (const bf16_t*)(a.ws + WS_UT);
    bf16_t* CST = (bf16_t*)(a.ws + WS_CST);
    float* chk = (float*)(a.ws + WS_CHK);
    const float* bend = chk; const float* mloc = chk + NGC * 4; float* mst = chk + 2 * NGC * 4;
    constexpr int E4 = 129 * 128 / 4, NPI = 8 * E4;
    const int T = blockIdx.x * 512 + tid, NT = gridDim.x * 512;
    for (int it = T; it < NPI; it += NT) {
        const int bh = it / E4, e4 = it % E4, bb = bh >> 2, h = bh & 3;
        float c0 = 0.f, c1 = 0.f, c2 = 0.f, c3 = 0.f, m = 0.f;
        const size_t estride = (size_t)4 * 129 * 128;
        const size_t e0 = ((size_t)(bb * 256) * 4 + h) * 129 * 128 + (size_t)e4 * 4;
        const int i0 = bb * 256 * 4 + h;
        u32x2 ub[16]; float be[16], ml[16];
#pragma unroll
        for (int j = 0; j < 16; ++j) { ub[j] = *(const u32x2*)(UT + e0 + (size_t)j * estride); be[j] = bend[i0 + 4 * j]; ml[j] = mloc[i0 + 4 * j]; }
        for (int grp = 0; grp < 16; ++grp) {
            u32x2 un[16]; float ben[16], mln[16];
            const int cn = (grp + 1 < 16 ? grp + 1 : grp) * 16;
#pragma unroll
            for (int j = 0; j < 16; ++j) { un[j] = *(const u32x2*)(UT + e0 + (size_t)(cn + j) * estride); ben[j] = bend[i0 + 4 * (cn + j)]; mln[j] = mloc[i0 + 4 * (cn + j)]; }
#pragma unroll
            for (int j = 0; j < 16; ++j) {
                const int cc = grp * 16 + j;
                u32x2 w; w.x = cvt_pk_bf16(c0, c1); w.y = cvt_pk_bf16(c2, c3);
                *(u32x2*)(CST + e0 + (size_t)cc * estride) = w;
                if (e4 == 0) mst[i0 + 4 * cc] = m;
                const float mn = fmaxf(be[j] + m, ml[j]);
                const float dec = fexp(be[j] + m - mn), sc = fexp(ml[j] - mn);
                c0 = dec * c0 + sc * bflo(ub[j].x); c1 = dec * c1 + sc * bfhi(ub[j].x); c2 = dec * c2 + sc * bflo(ub[j].y); c3 = dec * c3 + sc * bfhi(ub[j].y);
                m = mn;
            }
#pragma unroll
            for (int j = 0; j < 16; ++j) { ub[j] = un[j]; be[j] = ben[j]; ml[j] = mln[j]; }
        }
        const int e = e4 * 4, dv = e >> 7, dk = e & 127;
        if (dv < 128) { float* o = a.out + OFF_C_P + ((size_t)bh * 128 + dk) * 128 + dv; o[0] = c0; o[128] = c1; o[256] = c2; o[384] = c3; }
        else { float* o = a.out + OFF_N_P + (size_t)bh * 128 + dk; o[0] = c0; o[1] = c1; o[2] = c2; o[3] = c3; }
        if (e4 == 0) a.out[OFF_M_P + bh] = m;
    }
}

constexpr int QP = 136;
constexpr int C_QS = 0, C_KS = C_QS + 64 * QP * 2, C_VT = C_KS + 64 * QP * 2, C_CT = C_VT + 144 * TP * 2, C_SS = C_CT + 144 * QP * 2, C_END = C_SS + 512;
static_assert(C_END <= TAB_OFF, "phase C LDS");
struct CLoad { unsigned uq[11], uk[11], v[8]; u32x4 ct[5]; u32x2 mo[4]; float fg, ig, mprev; };
DI void c_issue(const KArgs& a, int gc, int h, int tid, int wave, int lane, CLoad& L) {
    const bf16_t* PROJ = (const bf16_t*)(a.ws + WS_PROJ);
    const float* gates = (const float*)(a.ws + WS_GATES);
    const float* mst = (const float*)(a.ws + WS_CHK) + 2 * NGC * 4;
    const bf16_t* CST = (const bf16_t*)(a.ws + WS_CST);
    const int row0 = gc * 64, idx = gc * 4 + h, s0 = 8 * wave, ch = 2 * lane, fr = lane & 15, g = lane >> 4;
    conv_load(a, PROJ, gc, s0, PQ + h * 128 + ch, L.uq);
    conv_load(a, PROJ, gc, s0, PK + h * 128 + ch, L.uk);
#pragma unroll
    for (int j = 0; j < 8; ++j) L.v[j] = *(const unsigned*)(PROJ + (size_t)(row0 + s0 + j) * NPROJ + PV + h * 128 + ch);
#pragma unroll
    for (int i = 0; i < 5; ++i) { const int p8 = tid + 512 * i; int dv = p8 >> 4; dv = dv > 128 ? 128 : dv; L.ct[i] = *(const u32x4*)(CST + ((size_t)idx * 129 + dv) * 128 + (p8 & 15) * 8); }
    const int t = 16 * (wave & 3) + fr, dh = wave >> 2;
#pragma unroll
    for (int q = 0; q < 4; ++q) L.mo[q] = *(const u32x2*)(PROJ + (size_t)(row0 + t) * NPROJ + PO + h * 128 + 16 * (4 * dh + q) + 4 * g);
    L.fg = gates[(size_t)(row0 + lane) * 8 + 4 + h]; L.ig = gates[(size_t)(row0 + lane) * 8 + h]; L.mprev = mst[idx];
}
DI void phase_mixC(const KArgs& a, LAS unsigned char* lds, int tid, int wave, int lane) {
    bf16_t* MIX = (bf16_t*)(a.ws + WS_HN);
    LAS bf16_t* Qs = (LAS bf16_t*)(lds + C_QS); LAS bf16_t* Ks = (LAS bf16_t*)(lds + C_KS); LAS bf16_t* VT = (LAS bf16_t*)(lds + C_VT); LAS bf16_t* CT = (LAS bf16_t*)(lds + C_CT);
    LAS float* SS = (LAS float*)(lds + C_SS);
    const int fr = lane & 15, g = lane >> 4, G = gridDim.x;
    for (int e = tid; e < 16 * 64; e += 512) VT[(128 + (e >> 6)) * TP + (e & 63)] = (e >> 6) == 0 ? (bf16_t)0x3F80 : (bf16_t)0;
    for (int p8 = tid; p8 < 15 * 16; p8 += 512) *(LAS u32x4*)(CT + (129 + (p8 >> 4)) * QP + (p8 & 15) * 8) = (u32x4){0u, 0u, 0u, 0u};
    __syncthreads();
    int it = blockIdx.x;
    if (it >= NGC * 4) return;
    CLoad L; c_issue(a, it >> 2, it & 3, tid, wave, lane, L);
    ConvW Wq, Wk; int hw = it & 3;
#define C_HLOAD() do { convw_load(a, PQ + hw * 128 + 2 * lane, Wq); convw_load(a, PK + hw * 128 + 2 * lane, Wk); } while (0)
    C_HLOAD();
    for (; it < NGC * 4; it += G) {
        const int gc = it >> 2, h = it & 3, row0 = gc * 64;
        if (h != hw) { hw = h; C_HLOAD(); }
        const float b = gate_cumsum(L.fg, lane);
        const float mprev = L.mprev;
        const float x = L.ig - b;
        float pm = x;
#pragma unroll
        for (int o = 1; o < 64; o <<= 1) { const float t = __shfl_up(pm, o); if (lane >= o) pm = fmaxf(pm, t); }
        const float mt = b + fmaxf(mprev, pm);
        const float winter = fexp(b + mprev - mt), bm = b - mt, em = fexp(-mt);
        {
            const int s0 = 8 * wave, ch = 2 * lane, sw = 8 * (ch >> 4);
            float q0[8], q1[8]; conv_math(Wq, L.uq, q0, q1);
#pragma unroll
            for (int j = 0; j < 8; ++j) *(LAS unsigned*)(Qs + (s0 + j) * QP + ch) = cvt_pk_bf16(q0[j], q1[j]);
            float k0[8], k1[8]; conv_math(Wk, L.uk, k0, k1);
#pragma unroll
            for (int j = 0; j < 8; ++j) *(LAS unsigned*)(Ks + (s0 + j) * QP + ch) = cvt_pk_bf16(k0[j] * 0.08838834764831845f, k1[j] * 0.08838834764831845f);
            store_vT(L.v, s0, VT, ch, sw);
#pragma unroll
            for (int i = 0; i < 5; ++i) { const int p8 = tid + 512 * i; if (p8 < 129 * 16) *(LAS u32x4*)(CT + (p8 >> 4) * QP + (p8 & 15) * 8) = L.ct[i]; }
        }
        u32x2 mo[4];
#pragma unroll
        for (int q = 0; q < 4; ++q) mo[q] = L.mo[q];
        __syncthreads();
        { const int itn = it + G < NGC * 4 ? it + G : it; c_issue(a, itn >> 2, itn & 3, tid, wave, lane, L); }
        const int tt = wave & 3, dh = wave >> 2;
        bf16x8 qB[4];
#pragma unroll
        for (int ks = 0; ks < 4; ++ks) qB[ks] = *(const LAS bf16x8*)(Qs + (16 * tt + fr) * QP + 32 * ks + 8 * g);
        f32x4 sacc[4];
#pragma unroll
        for (int i4 = 0; i4 < 4; ++i4) { sacc[i4] = (f32x4){0.f, 0.f, 0.f, 0.f};
#pragma unroll
            for (int ks = 0; ks < 4; ++ks) { const bf16x8 kA = *(const LAS bf16x8*)(Ks + (16 * i4 + fr) * QP + 32 * ks + 8 * g); sacc[i4] = MFMA16(kA, qB[ks], sacc[i4]); } }
        const int t = 16 * tt + fr;
        const float bm_t = __shfl(bm, t), wi_t = __shfl(winter, t), em_t = __shfl(em, t);
#pragma unroll
        for (int i4 = 0; i4 < 4; ++i4)
#pragma unroll
            for (int r = 0; r < 4; ++r) {
                const int s_ = 16 * i4 + 4 * g + r;
                const float xs = __shfl(x, s_);
                const float w = (s_ <= t) ? fexp(bm_t + xs) : 0.f;
                sacc[i4][r] *= w;
            }
        bf16x8 pB[2];
#pragma unroll
        for (int k2 = 0; k2 < 2; ++k2) pB[k2] = pack8(sacc[2 * k2], sacc[2 * k2 + 1]);
        f32x4 res[5];
#pragma unroll
        for (int q = 0; q < 5; ++q) {
            const int dvt = q < 4 ? 4 * dh + q : 8;
            f32x4 a1 = {0.f, 0.f, 0.f, 0.f}, a2 = {0.f, 0.f, 0.f, 0.f};
#pragma unroll
            for (int ks = 0; ks < 4; ++ks) { const bf16x8 cA = *(const LAS bf16x8*)(CT + (16 * dvt + fr) * QP + 32 * ks + 8 * g); a1 = MFMA16(cA, qB[ks], a1); }
#pragma unroll
            for (int k2 = 0; k2 < 2; ++k2) {
                const LAS bf16_t* vp = VT + (16 * dvt + fr) * TP; const int sw = 8 * (dvt & 7);
                const s16x4 lo = *(const LAS s16x4*)(vp + ((32 * k2 + 4 * g) ^ sw)), hi = *(const LAS s16x4*)(vp + ((32 * k2 + 16 + 4 * g) ^ sw));
                const bf16x8 vA = __builtin_shufflevector(lo, hi, 0, 1, 2, 3, 4, 5, 6, 7);
                a2 = MFMA16(vA, pB[k2], a2);
            }
            res[q] = a1 * wi_t + a2;
        }
        const float den = __shfl(res[4][0], fr);
        const float inv = 1.0f / fmaxf(fabsf(den), em_t);
        float ssq = 0.f;
#pragma unroll
        for (int q = 0; q < 4; ++q)
#pragma unroll
            for (int r = 0; r < 4; ++r) { const float hv = res[q][r] * inv; res[q][r] = hv; ssq += hv * hv; }
        ssq += __shfl_xor(ssq, 16); ssq += __shfl_xor(ssq, 32);
        f32x4 gm[4];
#pragma unroll
        for (int q = 0; q < 4; ++q) gm[q] = *(const f32x4*)(a.g_mlstm + h * 128 + 16 * (4 * dh + q) + 4 * g);
        if (g == 0) SS[dh * 64 + t] = ssq;
        __syncthreads();
        const float rs = 1.0f / sqrtf((SS[t] + SS[64 + t]) * (1.0f / 128.0f) + EPS);
#pragma unroll
        for (int q = 0; q < 4; ++q) {
            const int col = h * 128 + 16 * (4 * dh + q) + 4 * g;
            const float o0 = sigmoidf_(bflo(mo[q].x)) * res[q][0] * rs * gm[q][0], o1 = sigmoidf_(bfhi(mo[q].x)) * res[q][1] * rs * gm[q][1];
            const float o2 = sigmoidf_(bflo(mo[q].y)) * res[q][2] * rs * gm[q][2], o3 = sigmoidf_(bfhi(mo[q].y)) * res[q][3] * rs * gm[q][3];
            u32x2 w; w.x = cvt_pk_bf16(o0, o1); w.y = cvt_pk_bf16(o2, o3);
            *(u32x2*)(MIX + (size_t)(row0 + t) * DM + col) = w;
        }
        __syncthreads();
    }
#undef C_HLOAD
}

#define XB_TMO      128
#define XB_XCNT(j)  (256  + 64 * (j))
#define XB_XSUB(j)  (1280 + 64 * (j))
#define XB_XGEN(j)  (2304 + 64 * (j))
#define XB_TOP      3328
#define XB_TOPGEN   3392
#define XCD_BAR_WORDS 3456
#define XB_SPIN_CAP (1u << 18)

__device__ __forceinline__ unsigned xb_ld(unsigned* p)              { return __hip_atomic_load(p, __ATOMIC_RELAXED, __HIP_MEMORY_SCOPE_AGENT); }
__device__ __forceinline__ unsigned xb_add(unsigned* p, unsigned v) { return __hip_atomic_fetch_add(p, v, __ATOMIC_RELAXED, __HIP_MEMORY_SCOPE_AGENT); }
__device__ __forceinline__ unsigned xb_xcc_id() { return (unsigned)__builtin_amdgcn_s_getreg((3 << 11) | 20) & 0xFu; }
#define XB_SPIN(cond, bar) do { unsigned _sp = 0; while (cond) { __builtin_amdgcn_s_sleep(1); \
    if ((++_sp & 255u) == 0u) { if (xb_ld(&(bar)[XB_TMO])) break; if (_sp > XB_SPIN_CAP) { atomicAdd(&(bar)[XB_TMO], 1u); break; } } } } while (0)

struct XcdBarrier {
    unsigned* bar; unsigned x;
    volatile LAS unsigned* st;
};

__device__ __forceinline__ XcdBarrier xcd_barrier_post(unsigned* bar, volatile LAS unsigned* st) {
    XcdBarrier b; b.bar = bar; b.x = xb_xcc_id(); b.st = st;
    if (threadIdx.x == 0) (void)xb_add(&bar[XB_XCNT(b.x)], 1u);
    return b;
}
__device__ __forceinline__ void xcd_barrier_complete(unsigned* bar, unsigned x, unsigned& nloc, unsigned& nx) {
    const unsigned G = gridDim.x * gridDim.y * gridDim.z;
    unsigned sum, cnt, mine, sp = 0u;
    for (;;) {
        sum = 0u; cnt = 0u; mine = 0u;
#pragma unroll
        for (unsigned j = 0; j < 16; ++j) { const unsigned c = xb_ld(&bar[XB_XCNT(j)]); sum += c; cnt += (c > 0u) ? 1u : 0u; mine = (j == x) ? c : mine; }
        if (sum == G) break;
        __builtin_amdgcn_s_sleep(1);
        if ((++sp & 255u) == 0u) { if (xb_ld(&bar[XB_TMO])) break; if (sp > XB_SPIN_CAP) { atomicAdd(&bar[XB_TMO], 1u); break; } }
    }
    nloc = mine > 0u ? mine : 1u; nx = cnt > 0u ? cnt : 1u;
}

__device__ __forceinline__ void xcd_barrier(const XcdBarrier& b) {
    asm volatile("s_waitcnt vmcnt(0)" ::: "memory");
    __syncthreads();
    if (threadIdx.x == 0) {
        unsigned* bar = b.bar;
        __builtin_amdgcn_s_waitcnt(0);
        unsigned nloc = b.st[0], nx = b.st[1];
        if (nloc == 0u) { xcd_barrier_complete(bar, b.x, nloc, nx); b.st[0] = nloc; b.st[1] = nx; }
        const unsigned old = xb_add(&bar[XB_XSUB(b.x)], 1u);
        const unsigned gen = old / nloc;
        if (old + 1u == (gen + 1u) * nloc) {
            __builtin_amdgcn_fence(__ATOMIC_RELEASE, "agent");
            asm volatile("s_waitcnt vmcnt(0)" ::: "memory");
            const unsigned og = xb_add(&bar[XB_TOP], 1u);
            const unsigned tg = og / nx;
            if (og + 1u == (tg + 1u) * nx) xb_add(&bar[XB_TOPGEN], 1u);
            else XB_SPIN(xb_ld(&bar[XB_TOPGEN]) == tg, bar);
            __builtin_amdgcn_fence(__ATOMIC_ACQUIRE, "agent");
            xb_add(&bar[XB_XGEN(b.x)], 1u);
            asm volatile("s_waitcnt vmcnt(0)" ::: "memory");
        } else {
            XB_SPIN(xb_ld(&bar[XB_XGEN(b.x)]) == gen, bar);
            __builtin_amdgcn_fence(__ATOMIC_ACQUIRE, "agent");
            asm volatile("s_waitcnt vmcnt(0)" ::: "memory");
        }
    }
    __syncthreads();
}

constexpr int NPHASE = 14;
__global__ void __launch_bounds__(512, 2) fwd_megakernel(KArgs a) {
    extern __shared__ __attribute__((aligned(16))) unsigned char lds_raw[];
    LAS unsigned char* lds = (LAS unsigned char*)lds_raw;
    cg::grid_group grid = cg::this_grid();
    const int lo = a.ph_lo, hi = a.ph_hi;
    volatile LAS unsigned* bst = (volatile LAS unsigned*)(lds + BAR_LDS_OFF);
    if (threadIdx.x < 4) bst[threadIdx.x] = 0u;
    __syncthreads();
    XcdBarrier bar = xcd_barrier_post((unsigned*)a.ws, bst);
#define TIDS int tid = threadIdx.x; asm volatile("" : "+v"(tid)); const int lane = tid & 63, wave = __builtin_amdgcn_readfirstlane(tid >> 6); (void)lane; (void)wave
    const int G = gridDim.x;
    const float* mod = (const float*)(a.ws + WS_MOD);
    bf16_t* HN = (bf16_t*)(a.ws + WS_HN);
    bf16_t* ACT = (bf16_t*)(a.ws + WS_PROJ);
    bf16_t* PROJ = (bf16_t*)(a.ws + WS_PROJ);
    bf16_t* XB = (bf16_t*)a.out + (size_t)M * DM;
    constexpr bool FUSE_NORM = true;
    bf16_t* XB2 = (bf16_t*)(a.ws + WS_CST);
    float* PART = (float*)(a.ws + WS_UT);
    float* XS4 = (float*)(a.ws + WS_XS); float* XS5 = XS4 + (size_t)MS * DM;
#define IN(k) (lo <= (k) && (k) < hi)
#define SEAM(k) do { if (IN(k) && IN((k) + 1)) xcd_barrier(bar); } while (0)
    if (lo < 0) grid.sync();

    if (IN(0)) for (int rep = 0; rep < (DBG_REP == 0 ? 2 : 1); ++rep) { if (rep) grid.sync(); { TIDS; phase_prologue(a, lds, tid, wave, lane); } }
    SEAM(0);
    if (IN(1)) for (int rep = 0; rep < (DBG_REP == 1 ? 2 : 1); ++rep) { if (rep) grid.sync(); { TIDS; phase_norm<false, 0, false>(a, a.x_prompt, nullptr, a.x_sample, nullptr, a.g_norm, 0 * DM, 1 * DM, 0, 0.f, 0, lds, tid, wave, lane); } }
    SEAM(1);
    if (IN(2)) for (int rep = 0; rep < (DBG_REP == 2 ? 2 : 1); ++rep) { if (rep) grid.sync(); { pg8::Gemm g{HN, (const bf16_t*)(a.ws + WS_WUP1), M, NUP, DM}; pg8::StaticOrder S; S.init(M, NUP, G, (int)blockIdx.x, DM);
        pg8::EpiSwiglu E{ACT}; pg8::gemm_phase<pg8::EpiSwiglu, pg8::StaticOrder, true, true>(lds, g, S, E);
        { TIDS; const int thr = S.nwg % G, c = (int)blockIdx.x; if (rep == 0 && c >= thr) convert_group(a, 1, (c - thr) * 8 + wave, (G - thr) * 8, lds, wave, lane); } } }
    SEAM(2);
    if (IN(3)) for (int rep = 0; rep < (DBG_REP == 3 ? 2 : 1); ++rep) { if (rep) grid.sync(); { pg8::Gemm g{ACT, (const bf16_t*)(a.ws + WS_WDN1), M, DM, DFF}; pg8::SplitOrder S; S.init(DM, G, (int)blockIdx.x, DFF, 4);
        pg8::EpiResidT<false> E{a.x_prompt, nullptr, XB, mod, 2 * DM, 0.5f, PART}; pg8::gemm_phase<pg8::EpiResidT<false>, pg8::SplitOrder, true, true>(lds, g, S, E);
        { TIDS; const int thr = (S.P.nwg + S.NS * (MS / 256) * S.P.nN) % G, c = (int)blockIdx.x; if (rep == 0 && c >= thr) convert_group(a, 2, (c - thr) * 8 + wave, (G - thr) * 8, lds, wave, lane); } } }
    SEAM(3);
    if (IN(4)) for (int rep = 0; rep < (DBG_REP == 4 ? 2 : 1); ++rep) { if (rep) grid.sync(); { TIDS; phase_norm<true, 4, true>(a, nullptr, XB, a.x_sample, XS5, a.g_norm + DM, 3 * DM, 4 * DM, 2 * DM, 0.5f, 0, lds, tid, wave, lane); } }
    SEAM(4);
    if (IN(5)) for (int rep = 0; rep < (DBG_REP == 5 ? 2 : 1); ++rep) { if (rep) grid.sync(); { pg8::Gemm g{HN, (const bf16_t*)(a.ws + WS_WIN), M, NPROJ, DM}; pg8::StaticOrder S; S.init(M, NPROJ, G, (int)blockIdx.x, DM);
        pg8::EpiProj E{PROJ, a.out}; pg8::gemm_phase<pg8::EpiProj, pg8::StaticOrder, true, true>(lds, g, S, E);
        { TIDS; (void)lane; (void)wave; const int thr = S.nwg % G, c = (int)blockIdx.x; if (rep == 0 && c >= thr) kvc_convert(a, (c - thr) * 512 + tid, (G - thr) * 512); } } }
    SEAM(5);
    if (IN(6)) for (int rep = 0; rep < (DBG_REP == 6 ? 2 : 1); ++rep) { if (rep) grid.sync(); { TIDS; phase_mixA(a, lds, tid, wave, lane); } }
    SEAM(6);
    if (IN(7)) for (int rep = 0; rep < (DBG_REP == 7 ? 2 : 1); ++rep) { if (rep) grid.sync(); { TIDS; LAS float* tab = (LAS float*)(lds + TAB_OFF); for (int i = tid; i < 8 * 256; i += 512) { const int e = i & 255; tab[i] = a.rel_tab[(i >> 8) * 192 + (e > 191 ? 191 : e)] * LOG2E; } __syncthreads();
        phase_scan(a, tid);
        const int nscan = (8 * (129 * 128 / 4) + 511) / 512;
        if ((int)blockIdx.x >= nscan && G > nscan) for (int it = (int)blockIdx.x - nscan; it < ATT_N7; it += G - nscan) attn_item(a, it, lds, wave, lane); } }
    SEAM(7);
    if (IN(8)) for (int rep = 0; rep < (DBG_REP == 8 ? 2 : 1); ++rep) { if (rep) grid.sync(); { TIDS; phase_mixC(a, lds, tid, wave, lane); } }
    SEAM(8);
    if (IN(9)) for (int rep = 0; rep < (DBG_REP == 9 ? 2 : 1); ++rep) { if (rep) grid.sync(); { pg8::Gemm g{HN, (const bf16_t*)(a.ws + WS_WOUT), M, DM, DM}; pg8::SplitOrder S; S.init(DM, G, (int)blockIdx.x, DM, 2);
        pg8::EpiResidT<true> E{nullptr, XB, XB2, mod, 5 * DM, 1.0f, PART}; pg8::gemm_phase<pg8::EpiResidT<true>, pg8::SplitOrder, true, true>(lds, g, S, E); } }
    SEAM(9);
    if (IN(10)) for (int rep = 0; rep < (DBG_REP == 10 ? 2 : 1); ++rep) { if (rep) grid.sync(); { TIDS; phase_norm<false, 2, true>(a, nullptr, XB2, XS5, XS4, a.g_norm + 2 * DM, 6 * DM, 7 * DM, 5 * DM, 1.0f, 0, lds, tid, wave, lane); } }
    SEAM(10);
    if (IN(11)) for (int rep = 0; rep < (DBG_REP == 11 ? 2 : 1); ++rep) { if (rep) grid.sync(); { pg8::Gemm g{HN, (const bf16_t*)(a.ws + WS_WUP2), M, NUP, DM}; pg8::StaticOrder S; S.init(M, NUP, G, (int)blockIdx.x, DM);
        pg8::EpiSwiglu E{ACT}; pg8::gemm_phase<pg8::EpiSwiglu, pg8::StaticOrder, true, true>(lds, g, S, E); } }
    SEAM(11);
    if (IN(12)) for (int rep = 0; rep < (DBG_REP == 12 ? 2 : 1); ++rep) { if (rep) grid.sync(); { pg8::Gemm g{ACT, (const bf16_t*)(a.ws + WS_WDN2), M, DM, DFF}; pg8::SplitOrder S; S.init(DM, G, (int)blockIdx.x, DFF, 4);
        pg8::EpiResidNorm<0> E{XB2, HN, (void*)a.out, mod, PART, a.g_final, a.ws}; pg8::gemm_phase<pg8::EpiResidNorm<0>, pg8::SplitOrder, true, true>(lds, g, S, E); } }
    SEAM(12);
    if (IN(13)) for (int rep = 0; rep < (DBG_REP == 13 ? 2 : 1); ++rep) { if (rep) grid.sync(); { TIDS; phase_final_norm(a, HN, XS4, FUSE_NORM ? MP : 0, wave, lane); } }

    if (DBG_REP == 100) { for (int r = 0; r < 13; ++r) grid.sync(); }
#undef IN
#undef SEAM
}

extern "C" void kernel_launch(void* const* d_in, const int* in_sizes, int n_in, void* d_out, int out_size, void* d_ws, size_t ws_size, hipStream_t stream) {
    static int grid = 0;
    if (grid == 0) {
        if (n_in != 25 || (size_t)out_size != OUT_TOTAL || ws_size < WS_END) { fprintf(stderr, "kernel_launch: unexpected shapes: n_in %d out %d ws %zu\n", n_in, out_size, ws_size); grid = -1; return; }
        int dev = 0, cus = 0, per_cu = 0;
        hipGetDevice(&dev);
        hipDeviceGetAttribute(&cus, hipDeviceAttributeMultiprocessorCount, dev);
        hipFuncSetAttribute((const void*)fwd_megakernel, hipFuncAttributeMaxDynamicSharedMemorySize, LDS_BYTES);
        hipOccupancyMaxActiveBlocksPerMultiprocessor(&per_cu, (const void*)fwd_megakernel, 512, LDS_BYTES);
        if (per_cu < 1) { fprintf(stderr, "kernel_launch: occupancy query says %d blocks per CU\n", per_cu); per_cu = 1; }
        (void)hipGetLastError();
        grid = cus * per_cu;
    }
    if (grid < 0) return;
    if (hipMemsetAsync(d_ws, 0, CTL_ZERO_BYTES, stream) != hipSuccess) { fprintf(stderr, "kernel_launch: memset failed\n"); return; }
    KArgs a{};
    const float** f = (const float**)&a;
    for (int i = 0; i < 25; ++i) f[i] = (const float*)d_in[i];
    a.out = (float*)d_out; a.ws = (unsigned char*)d_ws;
#if MK_MULTI
    hipMemsetAsync(d_out, 0, (size_t)out_size * 4, stream);
    for (int p = 0; p < DBG_NPH; ++p) {
        a.ph_lo = p; a.ph_hi = p + 1;
        void* args[] = {&a};
        hipError_t e = hipLaunchCooperativeKernel((const void*)fwd_megakernel, dim3(grid), dim3(512), args, LDS_BYTES, stream);
        if (e != hipSuccess) { fprintf(stderr, "launch %d failed: %s\n", p, hipGetErrorString(e)); break; }
    }
#else
    a.ph_lo = 0; a.ph_hi = NPHASE;
    void* args[] = {&a};
    hipError_t e = hipLaunchCooperativeKernel((const void*)fwd_megakernel, dim3(grid), dim3(512), args, LDS_BYTES, stream);
    if (e != hipSuccess) fprintf(stderr, "cooperative launch failed: %s (grid %d)\n", hipGetErrorString(e), grid);
#endif
}
```

```cpp
#include <hip/hip_runtime.h>
#include <hip/hip_cooperative_groups.h>
#include <cstdio>
#include <cstdint>
namespace cg = cooperative_groups;

#ifndef MK_MULTI
#define MK_MULTI 0
#ifndef DBG_NPH
#define DBG_NPH 14
#endif
#endif

#ifndef DBG_REP
#define DBG_REP -1
#endif
#define DI __device__ __forceinline__
#define LAS __attribute__((address_space(3)))
typedef unsigned short bf16_t;
typedef short bf16x8 __attribute__((ext_vector_type(8)));
typedef short s16x4 __attribute__((ext_vector_type(4)));
typedef float f32x4 __attribute__((ext_vector_type(4)));
typedef unsigned u32x4 __attribute__((ext_vector_type(4)));
typedef unsigned u32x2 __attribute__((ext_vector_type(2)));

constexpr int DM = 1024, SEQ = 16384, NB = 2, DECB = 32, DECS = 64;
constexpr int MP = NB * SEQ, MS = DECB * DECS, M = MP + MS;
constexpr int DFF = 2816, NUP = 2 * DFF, DIN = 3592, NPROJ = 3584, NMOD = 9 * DM;
constexpr int NGC = M / 64;
constexpr int PQ = 0, PK = 512, PV = 1024, PO = 1536, PAQ = 2048, PAK = 2560, PAV = 3072;
constexpr float EPS = 1e-6f;
constexpr float LOG2E = 1.4426950408889634f;
constexpr size_t OFF_Y = 0, OFF_C_P = (size_t)M * DM, OFF_N_P = OFF_C_P + 131072, OFF_M_P = OFF_N_P + 1024, OFF_CONV_P = OFF_M_P + 8,
                 OFF_AK_P = OFF_CONV_P + 6144, OFF_AV_P = OFF_AK_P + 524288, OFF_C_S = OFF_AV_P + 524288, OFF_N_S = OFF_C_S + 2097152,
                 OFF_M_S = OFF_N_S + 16384, OFF_CONV_S = OFF_M_S + 128, OFF_AK_S = OFF_CONV_S + 98304, OFF_AV_S = OFF_AK_S + 1048576,
                 OUT_TOTAL = OFF_AV_S + 1048576;
constexpr size_t MiB = 1u << 20;
constexpr size_t WS_PREVB = 512 * 1024;
constexpr size_t WS_MOD = 1 * MiB, WS_WUP1 = 3 * MiB, WS_WDN1 = 14 * MiB, WS_WUP2 = 20 * MiB, WS_WDN2 = 31 * MiB, WS_WIN = 37 * MiB, WS_WOUT = 44 * MiB,
                 WS_GATES = 46 * MiB, WS_CHK = 48 * MiB, WS_HN = 49 * MiB, WS_PROJ = 117 * MiB, WS_UT = 355 * MiB, WS_CST = 424 * MiB, WS_XS = 494 * MiB, WS_END = 510 * MiB;
static_assert(WS_HN + (size_t)M * DM * 2 <= WS_PROJ && WS_PROJ + (size_t)M * NPROJ * 2 <= WS_UT && WS_UT + (size_t)NGC * 4 * 129 * 128 * 2 <= WS_CST &&
              WS_CST + (size_t)NGC * 4 * 129 * 128 * 2 <= WS_XS && WS_XS + (size_t)2 * MS * DM * 4 <= WS_END, "ws map");
constexpr int LDS_BYTES = 147456;
constexpr int TAB_OFF = 131072;
constexpr int BAR_LDS_OFF = LDS_BYTES - 64;
constexpr size_t CTL_ZERO_BYTES = 512 * 1024;
constexpr size_t CTL_SSQ_A = 64 * 1024, CTL_SSQ_B = 192 * 1024, CTL_CNT_A = 320 * 1024, CTL_CNT_B = 336 * 1024;

typedef float f32x2_t __attribute__((ext_vector_type(2))); typedef __bf16 bf16x2_t __attribute__((ext_vector_type(2)));
DI unsigned cvt_pk_bf16(float lo, float hi) { f32x2_t v = {lo, hi}; bf16x2_t b = __builtin_convertvector(v, bf16x2_t); return __builtin_bit_cast(unsigned, b); }
DI unsigned cvt_pk_asm(float lo, float hi) { unsigned r; asm volatile("v_cvt_pk_bf16_f32 %0, %1, %2" : "=v"(r) : "v"(lo), "v"(hi)); return r; }
DI float bf2f(unsigned short h) { return __uint_as_float((unsigned)h << 16); }
DI float bflo(unsigned w) { return __uint_as_float(w << 16); }
DI float bfhi(unsigned w) { return __uint_as_float(w & 0xffff0000u); }
DI float wave_sum(float v) {
#pragma unroll
    for (int o = 1; o < 64; o <<= 1) v += __shfl_xor(v, o);
    return v;
}
DI float wave_max(float v) {
#pragma unroll
    for (int o = 1; o < 64; o <<= 1) v = fmaxf(v, __shfl_xor(v, o));
    return v;
}
DI int modrow(int row) { return row < MP ? (row >> 14) : 2 + ((row - MP) >> 6); }
DI float fexp2(float x) { return __builtin_amdgcn_exp2f(x); }
DI float fexp(float x) { return __builtin_amdgcn_exp2f(x * 1.4426950408889634f); }
DI float frcp(float x) { return __builtin_amdgcn_rcpf(x); }
DI float sigmoidf_(float x) { return frcp(1.0f + fexp(-x)); }
DI float siluf_(float x) { return x * frcp(1.0f + fexp(-x)); }
#define MFMA16(a, b, c) __builtin_amdgcn_mfma_f32_16x16x32_bf16((a), (b), (c), 0, 0, 0)

namespace pg8 {
constexpr int BM = 256, BK = 64, HALF = 128, HTB = HALF * BK * 2, STAGE_BYTES = 8 * HTB, NXCD = 8, WGM = 8;
DI int lds_byte(int r, int c) { const int st = (r >> 4) * 2 + (c >> 5), rr = r & 15, cc = c & 31, ob = rr * 64 + cc * 2; return st * 1024 + (ob ^ (((ob >> 9) & 1) << 5)); }
DI void stage_rc(int b, int& R, int& C) { const int st = b / 1024, sb = b % 1024, swz = sb ^ (((sb >> 9) & 1) << 5); R = (st >> 1) * 16 + swz / 64; C = (st & 1) * 32 + (swz % 64) / 2; }
DI int perm32(int rho) { const int n = rho >> 4, i = rho & 15; return 8 * (i >> 2) + 4 * n + (i & 3); }
struct Unit { int pm, pn, k0, nt, part; };
struct Gemm { const bf16_t* A; const bf16_t* Bt; int M, N, K; };
struct StaticOrder {
    int nM, nN, nwg, G, c, ntk;
    DI void init(int M_, int N_, int G_, int c_, int K_) { nM = M_ / BM; nN = N_ / BM; nwg = nM * nN; G = G_; c = c_; ntk = K_ / BK; }
    DI void calc(int wg, int& pm, int& pn) const {
        int wgid = wg; { const int q = nwg / NXCD, r = nwg % NXCD, xcd = wgid % NXCD, off = wgid / NXCD; wgid = (xcd < r ? xcd * (q + 1) : r * (q + 1) + (xcd - r) * q) + off; }
        const int nig = WGM * nN, gid = wgid / nig, fm = gid * WGM, gsz = (nM - fm) < WGM ? (nM - fm) : WGM;
        pm = fm + ((wgid % nig) % gsz); pn = (wgid % nig) / gsz;
    }
    DI bool next(int i, Unit& u) const {
        const long L = (long)i * G + c; if (L >= nwg) return false;
        int wgid = (int)L; { const int q = nwg / NXCD, r = nwg % NXCD, xcd = wgid % NXCD, off = wgid / NXCD; wgid = (xcd < r ? xcd * (q + 1) : r * (q + 1) + (xcd - r) * q) + off; }
        const int nig = WGM * nN, gid = wgid / nig, fm = gid * WGM, gsz = (nM - fm) < WGM ? (nM - fm) : WGM;
        u.pm = fm + ((wgid % nig) % gsz); u.pn = (wgid % nig) / gsz; u.k0 = 0; u.nt = ntk; u.part = -1; return true;
    }
    DI void a_ready(const Unit&) const {}
    DI void done(const Unit&) const {}
};

struct SplitOrder {
    StaticOrder P; int NS, q1, q3;
    DI void init(int N_, int G_, int c_, int K_, int NS_) { P.init(MP, N_, G_, c_, K_); NS = NS_; const int nt = K_ / BK;
        if (NS_ == 4) { q1 = ((nt / 4) + 1) & ~1; q3 = 2 * q1 + (((nt - 2 * q1) / 2) & ~1); } else { q1 = nt / 2; q3 = nt; } }
    DI bool next(int i, Unit& u) const {
        const long L = (long)i * P.G + P.c;
        const int per = (MS / BM) * P.nN, total = P.nwg + NS * per;
        const bool isp = L < P.nwg;
        const int Lc = (int)(L < total ? L : total - 1);
        int ppm, ppn; P.calc(isp ? Lc : 0, ppm, ppn);
        const int j = isp ? 0 : Lc - P.nwg, part = j / per, rem = j % per;
        const int b = part == 3 ? q3 : part * q1;
        const int e = part == NS - 1 ? P.ntk : (part == 2 ? q3 : (part + 1) * q1);
        u.pm = isp ? ppm : MP / BM + rem / P.nN; u.pn = isp ? ppn : rem % P.nN; u.part = isp ? -1 : part; u.k0 = isp ? 0 : b; u.nt = isp ? P.ntk : e - b;
        return L < total;
    }
    DI void a_ready(const Unit&) const {}
    DI void done(const Unit&) const {}
};


struct EpiSwiglu {
    static constexpr bool PERM = true, AFTER_DRAIN = false;
    bf16_t* O;
    DI void operator()(const f32x4 (&acc)[2][2][4][2], const Unit& u, int wr, int wc, int fr, int fq) const {
        const int row0 = u.pm * BM + wr * 64 + fr, col0 = u.pn * HALF + wc * 32 + 8 * fq;
#pragma unroll
        for (int ai = 0; ai < 2; ++ai)
#pragma unroll
            for (int m = 0; m < 4; ++m) {
                bf16_t* p = O + (size_t)(row0 + ai * HALF + m * 16) * DFF + col0;
                f32x4 o4[2];
#pragma unroll
                for (int n = 0; n < 2; ++n) {
                    const f32x4 g4 = acc[ai][0][m][n], u4 = acc[ai][1][m][n];
                    const f32x4 t = g4 * (-LOG2E);
                    f32x4 e; e[0] = __builtin_amdgcn_exp2f(t[0]); e[1] = __builtin_amdgcn_exp2f(t[1]); e[2] = __builtin_amdgcn_exp2f(t[2]); e[3] = __builtin_amdgcn_exp2f(t[3]);
                    const f32x4 d = e + 1.0f;
                    f32x4 r; r[0] = __builtin_amdgcn_rcpf(d[0]); r[1] = __builtin_amdgcn_rcpf(d[1]); r[2] = __builtin_amdgcn_rcpf(d[2]); r[3] = __builtin_amdgcn_rcpf(d[3]);
                    o4[n] = (g4 * u4) * r;
                }
                u32x4 w; w.x = cvt_pk_asm(o4[0][0], o4[0][1]); w.y = cvt_pk_asm(o4[0][2], o4[0][3]); w.z = cvt_pk_asm(o4[1][0], o4[1][1]); w.w = cvt_pk_asm(o4[1][2], o4[1][3]);
                *(u32x4*)p = w;
            }
    }
};
template <bool B16IN>
struct EpiResidT {
    static constexpr bool PERM = true, AFTER_DRAIN = false;
    const float* base_f; const bf16_t* base_h; bf16_t* out_h; const float* mod; int gate_off; float coef; float* part;
    DI void operator()(const f32x4 (&acc)[2][2][4][2], const Unit& u, int wr, int wc, int fr, int fq) const {
        const int row0 = u.pm * BM + wr * 64 + fr, col0 = u.pn * BM + wc * 32 + 8 * fq;
        if (u.part >= 0) {
#pragma unroll
            for (int ai = 0; ai < 2; ++ai)
#pragma unroll
                for (int m = 0; m < 4; ++m) {
                    float* op = part + ((size_t)u.part * MS + (size_t)(row0 + ai * HALF + m * 16 - MP)) * DM;
#pragma unroll
                    for (int bj = 0; bj < 2; ++bj)
#pragma unroll
                        for (int n = 0; n < 2; ++n) *(f32x4*)(op + col0 + bj * HALF + 4 * n) = acc[ai][bj][m][n];
                }
            return;
        }
#pragma unroll
        for (int ai = 0; ai < 2; ++ai)
#pragma unroll
            for (int m = 0; m < 4; ++m) {
                const int row = row0 + ai * HALF + m * 16;
                const float* gp = mod + (size_t)(row >> 14) * NMOD + gate_off;
#pragma unroll
                for (int bj = 0; bj < 2; ++bj) {
                    const int c = col0 + bj * HALF;
                    f32x4 b0, b1;
                    if (B16IN) { const u32x4 w = *(const u32x4*)(base_h + (size_t)row * DM + c);
                        b0 = (f32x4){bflo(w.x), bfhi(w.x), bflo(w.y), bfhi(w.y)}; b1 = (f32x4){bflo(w.z), bfhi(w.z), bflo(w.w), bfhi(w.w)}; }
                    else { b0 = *(const f32x4*)(base_f + (size_t)row * DM + c); b1 = *(const f32x4*)(base_f + (size_t)row * DM + c + 4); }
                    const f32x4 g0 = *(const f32x4*)(gp + c), g1 = *(const f32x4*)(gp + c + 4);
                    const f32x4 o0 = b0 + (g0 * coef) * acc[ai][bj][m][0], o1 = b1 + (g1 * coef) * acc[ai][bj][m][1];
                    u32x4 w; w.x = cvt_pk_asm(o0[0], o0[1]); w.y = cvt_pk_asm(o0[2], o0[3]); w.z = cvt_pk_asm(o1[0], o1[1]); w.w = cvt_pk_asm(o1[2], o1[3]);
                    *(u32x4*)(out_h + (size_t)row * DM + c) = w;
                }
            }
    }
};
template <int MODE>
struct EpiResidNorm {
    static constexpr bool PERM = true, AFTER_DRAIN = false;
    const bf16_t* base_h; bf16_t* out_h; void* dst; const float* mod; float* part; const float* g; unsigned char* ctl;
    static constexpr int gate_off = MODE == 0 ? 8 * DM : 5 * DM, shift_off = 6 * DM, scale_off = 7 * DM;
    static constexpr float coef = MODE == 0 ? 0.5f : 1.0f;
    DI void operator()(const f32x4 (&acc)[2][2][4][2], const Unit& u, int wr, int wc, int fr, int fq) const {
        float* sumsq = (float*)(ctl + (MODE == 0 ? CTL_SSQ_B : CTL_SSQ_A)); unsigned* cnt = (unsigned*)(ctl + (MODE == 0 ? CTL_CNT_B : CTL_CNT_A));
        float* y = (float*)dst; bf16_t* hn = (bf16_t*)dst;
        const int row0 = u.pm * BM + wr * 64 + fr, col0 = u.pn * BM + wc * 32 + 8 * fq;
        if (u.part >= 0) {
#pragma unroll
            for (int ai = 0; ai < 2; ++ai)
#pragma unroll
                for (int m = 0; m < 4; ++m) {
                    float* op = part + ((size_t)u.part * MS + (size_t)(row0 + ai * HALF + m * 16 - MP)) * DM;
#pragma unroll
                    for (int bj = 0; bj < 2; ++bj)
#pragma unroll
                        for (int n = 0; n < 2; ++n) *(f32x4*)(op + col0 + bj * HALF + 4 * n) = acc[ai][bj][m][n];
                }
            return;
        }
        const float* md = mod + (size_t)(row0 >> 14) * NMOD;
        const unsigned rb = (unsigned)(row0 * DM + col0);
        float ssq[8];
#pragma unroll
        for (int k = 0; k < 8; ++k) ssq[k] = 0.f;
#pragma unroll
        for (int bj = 0; bj < 2; ++bj) {
            const int c = col0 + bj * HALF;
            const f32x4 g0 = *(const f32x4*)(md + gate_off + c) * coef, g1 = *(const f32x4*)(md + gate_off + c + 4) * coef;
#pragma unroll
            for (int ai = 0; ai < 2; ++ai)
#pragma unroll
                for (int m = 0; m < 4; ++m) {
                    const unsigned eo = rb + (unsigned)((ai * HALF + m * 16) * DM + bj * HALF);
                    const u32x4 w = *(const u32x4*)((const char*)base_h + eo * 2u);
                    const f32x4 b0 = {bflo(w.x), bfhi(w.x), bflo(w.y), bfhi(w.y)}, b1 = {bflo(w.z), bfhi(w.z), bflo(w.w), bfhi(w.w)};
                    const f32x4 x0 = b0 + g0 * acc[ai][bj][m][0], x1 = b1 + g1 * acc[ai][bj][m][1];
                    ssq[ai * 4 + m] += (x0[0] * x0[0] + x0[1] * x0[1]) + (x0[2] * x0[2] + x0[3] * x0[3]) + (x1[0] * x1[0] + x1[1] * x1[1]) + (x1[2] * x1[2] + x1[3] * x1[3]);
                    u32x4 p; p.x = cvt_pk_bf16(x0[0], x0[1]); p.y = cvt_pk_bf16(x0[2], x0[3]); p.z = cvt_pk_bf16(x1[0], x1[1]); p.w = cvt_pk_bf16(x1[2], x1[3]);
                    *(u32x4*)((char*)out_h + eo * 2u) = p;
                }
        }
#pragma unroll
        for (int k = 0; k < 8; ++k) { float s = ssq[k]; s += __shfl_xor(s, 16); s += __shfl_xor(s, 32); ssq[k] = s; }
        if (fq == 0) {
#pragma unroll
            for (int k = 0; k < 8; ++k) (void)__hip_atomic_fetch_add(sumsq + row0 + (k >> 2) * HALF + (k & 3) * 16, ssq[k], __ATOMIC_RELAXED, __HIP_MEMORY_SCOPE_AGENT);
        }
        asm volatile("s_waitcnt vmcnt(0)" ::: "memory");
        unsigned* cw = cnt + 16 * u.pm;
        if (fq == 0 && fr == 0) (void)__hip_atomic_fetch_add(cw, 1u, __ATOMIC_RELAXED, __HIP_MEMORY_SCOPE_AGENT);
        { unsigned sp = 0; while ((unsigned)__builtin_amdgcn_readfirstlane(__hip_atomic_load(cw, __ATOMIC_RELAXED, __HIP_MEMORY_SCOPE_AGENT)) < 32u) { __builtin_amdgcn_s_sleep(2); if (++sp > (1u << 20)) break; } }
        asm volatile("" ::: "memory");
        float rstd[8];
#pragma unroll
        for (int k = 0; k < 8; ++k) { const float t = __hip_atomic_load(sumsq + row0 + (k >> 2) * HALF + (k & 3) * 16, __ATOMIC_RELAXED, __HIP_MEMORY_SCOPE_AGENT); rstd[k] = __builtin_amdgcn_rsqf(t * (1.0f / DM) + EPS); }
#pragma unroll
        for (int bj = 0; bj < 2; ++bj) {
            const int c = col0 + bj * HALF;
            f32x4 A0 = *(const f32x4*)(g + c), A1 = *(const f32x4*)(g + c + 4), B0 = {0.f, 0.f, 0.f, 0.f}, B1 = {0.f, 0.f, 0.f, 0.f};
            if (MODE == 1) { A0 = A0 * (*(const f32x4*)(md + scale_off + c) + 1.0f); A1 = A1 * (*(const f32x4*)(md + scale_off + c + 4) + 1.0f); B0 = *(const f32x4*)(md + shift_off + c); B1 = *(const f32x4*)(md + shift_off + c + 4); }
#pragma unroll
            for (int ai = 0; ai < 2; ++ai)
#pragma unroll
                for (int m = 0; m < 4; ++m) {
                    const unsigned eo = rb + (unsigned)((ai * HALF + m * 16) * DM + bj * HALF); const float rs = rstd[ai * 4 + m];
                    const u32x4 p = *(const u32x4*)((const char*)out_h + eo * 2u);
                    const f32x4 x0 = {bflo(p.x), bfhi(p.x), bflo(p.y), bfhi(p.y)}, x1 = {bflo(p.z), bfhi(p.z), bflo(p.w), bfhi(p.w)};
                    if (MODE == 0) {
                        *(f32x4*)((char*)y + eo * 4u) = (x0 * rs) * A0; *(f32x4*)((char*)y + eo * 4u + 16u) = (x1 * rs) * A1;
                    } else {
                        const f32x4 h0 = (x0 * rs) * A0 + B0, h1 = (x1 * rs) * A1 + B1;
                        u32x4 v; v.x = cvt_pk_bf16(h0[0], h0[1]); v.y = cvt_pk_bf16(h0[2], h0[3]); v.z = cvt_pk_bf16(h1[0], h1[1]); v.w = cvt_pk_bf16(h1[2], h1[3]);
                        *(u32x4*)((char*)hn + eo * 2u) = v;
                    }
                }
        }
    }
};
struct EpiProj {
    static constexpr bool PERM = true, AFTER_DRAIN = false;
    bf16_t* P; float* dout;
    DI void operator()(const f32x4 (&acc)[2][2][4][2], const Unit& u, int wr, int wc, int fr, int fq) const {
        const int row0 = u.pm * BM + wr * 64 + fr, col0 = u.pn * BM + wc * 32 + 8 * fq;
#pragma unroll
        for (int ai = 0; ai < 2; ++ai)
#pragma unroll
            for (int m = 0; m < 4; ++m) {
                const int row = row0 + ai * HALF + m * 16;
#pragma unroll
                for (int bj = 0; bj < 2; ++bj) {
                    const int col = col0 + bj * HALF;
                    const f32x4 v0 = acc[ai][bj][m][0], v1 = acc[ai][bj][m][1];
                    u32x4 w; w.x = cvt_pk_asm(v0[0], v0[1]); w.y = cvt_pk_asm(v0[2], v0[3]); w.z = cvt_pk_asm(v1[0], v1[1]); w.w = cvt_pk_asm(v1[2], v1[3]);
                    *(u32x4*)(P + (size_t)row * NPROJ + col) = w;
                    float* dst = nullptr;
                    if (col < 1024) {
                        if (row < MP) { const int t = row & (SEQ - 1); if (t >= SEQ - 3) dst = dout + OFF_CONV_P + (size_t)((row >> 14) * 3 + (t - (SEQ - 3))) * 1024 + col; }
                        else { const int t = (row - MP) & 63; if (t >= 61) dst = dout + OFF_CONV_S + (size_t)(((row - MP) >> 6) * 3 + (t - 61)) * 1024 + col; }
                    } else if (col >= PAK) {
                        const bool isv = col >= PAV; const int cc = col - (isv ? PAV : PAK);
                        if (row < MP) { const int t = row & (SEQ - 1); if (t >= SEQ - 512) dst = dout + (isv ? OFF_AV_P : OFF_AK_P) + (size_t)((row >> 14) * 512 + (t - (SEQ - 512))) * 512 + cc; }
                        else dst = dout + (isv ? OFF_AV_S : OFF_AK_S) + (size_t)(row - MP) * 512 + cc;
                    }
                    if (dst) { *(f32x4*)dst = v0; *(f32x4*)(dst + 4) = v1; }
                }
            }
    }
};

template <class Epi, class Sched, bool ALIGN_EPI = false, bool SP2 = false>
DI void gemm_phase(LAS unsigned char* lds, const Gemm g, const Sched& S, const Epi& E) {
    const int tid = threadIdx.x, wid = __builtin_amdgcn_readfirstlane(tid >> 6), lane = tid & 63, wr = wid >> 2, wc = wid & 3, fr = lane & 15, fq = lane >> 4;
    const int K = g.K;
    unsigned voffA[2], voffB[2];
#pragma unroll
    for (int i = 0; i < 2; ++i) { int R, C; stage_rc(tid * 16 + i * 8192, R, C); const int Rb = Epi::PERM ? ((R & ~31) + perm32(R & 31)) : R;
        voffA[i] = (unsigned)(R * K + C) * 2u; voffB[i] = (unsigned)(Rb * K + C) * 2u; }
    const size_t kstep = (size_t)(BK * 2);
    const size_t hstep = (size_t)HALF * K * 2;
    const size_t tstep = 2 * hstep;
    const unsigned ldsw = (unsigned)wid * 1024u;
    const int aoff = lds_byte(wr * 64 + fr, fq * 8), boff = lds_byte(wc * 32 + fr, fq * 8);
#define PG8_SA(b, h) (((b) * 2 + (h)) * HTB)
#define PG8_SB(b, h) ((4 + (b) * 2 + (h)) * HTB)
#define PG8_STAGE(bufoff, gbase, voff) do { _Pragma("unroll") for (int _i = 0; _i < 2; ++_i) \
        __builtin_amdgcn_global_load_lds((const unsigned*)((const char*)(gbase) + (voff)[_i]), (LAS unsigned*)(lds + (bufoff) + ldsw + _i * 8192), 16, 0, 0); } while (0)
#define PG8_LDA(dst, b, h) do { _Pragma("unroll") for (int m = 0; m < 4; ++m) _Pragma("unroll") for (int k = 0; k < 2; ++k) dst[m][k] = *(const LAS bf16x8*)(lds + PG8_SA(b, h) + aoff + m * 2048 + k * 1024); } while (0)
#define PG8_LDB(dst, b, h) do { _Pragma("unroll") for (int n = 0; n < 2; ++n) _Pragma("unroll") for (int k = 0; k < 2; ++k) dst[n][k] = *(const LAS bf16x8*)(lds + PG8_SB(b, h) + boff + n * 2048 + k * 1024); } while (0)
#define PG8_MMA(ai, bj, At, Bt) do { __builtin_amdgcn_s_setprio(1); _Pragma("unroll") for (int m = 0; m < 4; ++m) _Pragma("unroll") for (int n = 0; n < 2; ++n) _Pragma("unroll") for (int k = 0; k < 2; ++k) \
        acc[ai][bj][m][n] = __builtin_amdgcn_mfma_f32_16x16x32_bf16(Bt[n][k], At[m][k], acc[ai][bj][m][n], 0, 0, 0); __builtin_amdgcn_s_setprio(0); } while (0)
#define PG8_WAIT_V(n) asm volatile("s_waitcnt vmcnt(" #n ")" ::: "memory")
#define PG8_WAIT_L(n) asm volatile("s_waitcnt lgkmcnt(" #n ")" ::: "memory")
#define PG8_BAR __builtin_amdgcn_s_barrier()
#define PG8_SCHED __builtin_amdgcn_sched_barrier(0)
    Unit cur, nxt; int ui = 0;
    if (!S.next(0, cur)) return;
    f32x4 acc[2][2][4][2];
#pragma unroll
    for (int a = 0; a < 2; ++a)
#pragma unroll
        for (int b = 0; b < 2; ++b)
#pragma unroll
            for (int m = 0; m < 4; ++m)
#pragma unroll
                for (int n = 0; n < 2; ++n) acc[a][b][m][n] = (f32x4){0.f, 0.f, 0.f, 0.f};
    bf16x8 At[4][2], B0[2][2], B1[2][2];
    const char* cA = (const char*)g.A + (size_t)cur.pm * tstep + (size_t)cur.k0 * kstep; const char* cB = (const char*)g.Bt + (size_t)cur.pn * tstep + (size_t)cur.k0 * kstep;
    S.a_ready(cur);
    if constexpr (SP2) {
        PG8_STAGE(PG8_SB(0, 0), cB, voffB); PG8_STAGE(PG8_SB(0, 1), cB + hstep, voffB); PG8_STAGE(PG8_SA(0, 0), cA, voffA); PG8_STAGE(PG8_SA(0, 1), cA + hstep, voffA);
        if (wr == 1) PG8_BAR;
        PG8_WAIT_V(2); PG8_BAR;
        PG8_STAGE(PG8_SB(1, 0), cB + kstep, voffB); PG8_STAGE(PG8_SA(1, 0), cA + kstep, voffA); PG8_STAGE(PG8_SB(1, 1), cB + hstep + kstep, voffB);
        PG8_WAIT_V(6); PG8_BAR;
    } else {
        PG8_STAGE(PG8_SB(0, 0), cB, voffB); PG8_STAGE(PG8_SA(0, 0), cA, voffA); PG8_STAGE(PG8_SB(0, 1), cB + hstep, voffB); PG8_STAGE(PG8_SA(0, 1), cA + hstep, voffA);
        if (wr == 1) PG8_BAR;
        PG8_WAIT_V(4); PG8_BAR;
        PG8_STAGE(PG8_SB(1, 0), cB + kstep, voffB); PG8_STAGE(PG8_SA(1, 0), cA + kstep, voffA); PG8_STAGE(PG8_SB(1, 1), cB + hstep + kstep, voffB);
        PG8_WAIT_V(6); PG8_BAR;
    }
    for (;;) {
        const bool has_next = S.next(ui + 1, nxt);
        const char* nA = has_next ? (const char*)g.A + (size_t)nxt.pm * tstep + (size_t)nxt.k0 * kstep : cA; const char* nB = has_next ? (const char*)g.Bt + (size_t)nxt.pn * tstep + (size_t)nxt.k0 * kstep : cB;
        const int nt = cur.nt;
        for (int t = 0; t < nt; t += 2) {
            const bool last = (t == nt - 2);
            const char* a1 = cA + (size_t)(t + 1) * kstep;
            const char* a2 = last ? nA : cA + (size_t)(t + 2) * kstep; const char* b2 = last ? nB : cB + (size_t)(t + 2) * kstep;
            const char* a3 = a2 + kstep; const char* b3 = b2 + kstep;
            if (last && has_next) S.a_ready(nxt);
            if constexpr (SP2) {
            PG8_LDB(B0, 0, 0); PG8_LDB(B1, 0, 1); PG8_SCHED; PG8_LDA(At, 0, 0); PG8_STAGE(PG8_SA(1, 1), a1 + hstep, voffA);
            PG8_WAIT_V(8); PG8_WAIT_L(0); PG8_BAR; PG8_MMA(0, 0, At, B0); PG8_MMA(0, 1, At, B1); PG8_BAR; PG8_SCHED;
            PG8_LDA(At, 0, 1); PG8_STAGE(PG8_SB(0, 0), b2, voffB); PG8_STAGE(PG8_SB(0, 1), b2 + hstep, voffB); PG8_STAGE(PG8_SA(0, 0), a2, voffA);
            PG8_WAIT_V(8); PG8_WAIT_L(0); PG8_BAR; PG8_MMA(1, 0, At, B0); PG8_MMA(1, 1, At, B1); PG8_BAR; PG8_SCHED;
            PG8_LDB(B0, 1, 0); PG8_LDB(B1, 1, 1); PG8_SCHED; PG8_LDA(At, 1, 0); PG8_STAGE(PG8_SA(0, 1), a2 + hstep, voffA);
            PG8_WAIT_V(8); PG8_WAIT_L(0); PG8_BAR; PG8_MMA(0, 0, At, B0); PG8_MMA(0, 1, At, B1); PG8_BAR; PG8_SCHED;
            PG8_LDA(At, 1, 1); PG8_STAGE(PG8_SB(1, 0), b3, voffB); PG8_STAGE(PG8_SB(1, 1), b3 + hstep, voffB); PG8_STAGE(PG8_SA(1, 0), a3, voffA);
            PG8_WAIT_V(8); PG8_WAIT_L(0); PG8_BAR; PG8_MMA(1, 0, At, B0); PG8_MMA(1, 1, At, B1); PG8_BAR; PG8_SCHED;
            } else {
            PG8_LDB(B0, 0, 0); PG8_SCHED; PG8_LDA(At, 0, 0); PG8_STAGE(PG8_SA(1, 1), a1 + hstep, voffA);
            PG8_WAIT_L(8); PG8_BAR; PG8_WAIT_L(0); PG8_MMA(0, 0, At, B0); PG8_BAR; PG8_SCHED;
            PG8_LDB(B1, 0, 1); PG8_STAGE(PG8_SB(0, 0), b2, voffB);
            PG8_BAR; PG8_WAIT_L(0); PG8_MMA(0, 1, At, B1); PG8_BAR;
            PG8_LDA(At, 0, 1); PG8_STAGE(PG8_SA(0, 0), a2, voffA);
            PG8_BAR; PG8_WAIT_L(0); PG8_MMA(1, 0, At, B0); PG8_BAR; PG8_SCHED;
            PG8_STAGE(PG8_SB(0, 1), b2 + hstep, voffB);
            PG8_WAIT_V(6); PG8_BAR; PG8_MMA(1, 1, At, B1); PG8_BAR;
            PG8_LDB(B0, 1, 0); PG8_SCHED; PG8_LDA(At, 1, 0); PG8_STAGE(PG8_SA(0, 1), a2 + hstep, voffA);
            PG8_WAIT_L(8); PG8_BAR; PG8_WAIT_L(0); PG8_MMA(0, 0, At, B0); PG8_BAR; PG8_SCHED;
            PG8_LDB(B1, 1, 1); PG8_STAGE(PG8_SB(1, 0), b3, voffB);
            PG8_BAR; PG8_WAIT_L(0); PG8_MMA(0, 1, At, B1); PG8_BAR;
            PG8_LDA(At, 1, 1); PG8_STAGE(PG8_SA(1, 0), a3, voffA);
            PG8_BAR; PG8_WAIT_L(0); PG8_MMA(1, 0, At, B0); PG8_BAR; PG8_SCHED;
            PG8_STAGE(PG8_SB(1, 1), b3 + hstep, voffB);
            PG8_WAIT_V(6); PG8_BAR; PG8_MMA(1, 1, At, B1); PG8_BAR;
            }
        }
        if constexpr (ALIGN_EPI) { if (wr == 0) PG8_BAR; }
        if constexpr (!Epi::AFTER_DRAIN) { E(acc, cur, wr, wc, fr, fq); S.done(cur); }
        if (!has_next) break;
#pragma unroll
        for (int a = 0; a < 2; ++a)
#pragma unroll
            for (int b = 0; b < 2; ++b)
#pragma unroll
                for (int m = 0; m < 4; ++m)
#pragma unroll
                    for (int n = 0; n < 2; ++n) acc[a][b][m][n] = (f32x4){0.f, 0.f, 0.f, 0.f};
        cur = nxt; cA = nA; cB = nB; ++ui;
        if constexpr (ALIGN_EPI) { if (wr == 1) PG8_BAR; }
    }
    PG8_WAIT_V(0);
    if constexpr (!ALIGN_EPI) { if (wr == 0) PG8_BAR; }
    PG8_BAR;
#undef PG8_SA
#undef PG8_SB
#undef PG8_STAGE
#undef PG8_LDA
#undef PG8_LDB
#undef PG8_MMA
#undef PG8_WAIT_V
#undef PG8_WAIT_L
#undef PG8_BAR
#undef PG8_SCHED
}
}

struct KArgs {
    const float *x_prompt, *x_sample, *st_C, *st_n, *st_m, *st_conv, *cache_k, *cache_v, *c_prompt, *c_sample, *w_ada, *b_ada, *g_norm,
                *w_up1, *w_dn1, *w_up2, *w_dn2, *w_in, *conv_w, *conv_b, *b_gates, *g_mlstm, *rel_tab, *w_out, *g_final;
    float* out; unsigned char* ws;
    int ph_lo, ph_hi;
};

DI void transpose_item(const float* W, int ldw, int src_col0, int k0, bf16_t* WT, int K, int dest_row0, LAS float* scr, int lane) {
#pragma unroll 8
    for (int i = 0; i < 32; ++i) { const int kk = 2 * i + (lane >> 5); scr[kk * 33 + (lane & 31)] = W[(size_t)(k0 + kk) * ldw + src_col0 + (lane & 31)]; }
    asm volatile("s_waitcnt lgkmcnt(0)" ::: "memory");
    const int c = lane & 7;
#pragma unroll
    for (int j = 0; j < 4; ++j) { const int n = (lane >> 3) + 8 * j; const LAS float* s = scr + (8 * c) * 33 + n;
        u32x4 o; o.x = cvt_pk_bf16(s[0 * 33], s[1 * 33]); o.y = cvt_pk_bf16(s[2 * 33], s[3 * 33]); o.z = cvt_pk_bf16(s[4 * 33], s[5 * 33]); o.w = cvt_pk_bf16(s[6 * 33], s[7 * 33]);
        *(u32x4*)(WT + (size_t)(dest_row0 + n) * K + k0 + 8 * c) = o; }
    asm volatile("s_waitcnt lgkmcnt(0)" ::: "memory");
}
DI void up_item(const float* W, bf16_t* WT, int it, LAS float* scr, int lane) {
    const int kb = it / 176, nb = it % 176, n0 = 32 * nb; const bool isu = n0 >= DFF; const int hid = isu ? n0 - DFF : n0;
    transpose_item(W, NUP, n0, 64 * kb, WT, DM, (hid >> 7) * 256 + (isu ? 128 : 0) + (hid & 127), scr, lane);
}
DI void convert_group(const KArgs& a, int grp, int widx, int nw, LAS unsigned char* lds, int wave, int lane) {
    LAS float* scr = (LAS float*)(lds + wave * 8448);
    constexpr int I_UP = 16 * 176, I_DN = 44 * 32, I_IN = 16 * 112, I_OUT = 16 * 32;
    if (grp == 0) {
        for (int r = widx; r < I_UP; r += nw) up_item(a.w_up1, (bf16_t*)(a.ws + WS_WUP1), r, scr, lane);
    } else if (grp == 1) {
        for (int r = widx; r < I_DN + I_IN + I_OUT; r += nw) {
            if (r < I_DN) transpose_item(a.w_dn1, DM, 32 * (r % 32), 64 * (r / 32), (bf16_t*)(a.ws + WS_WDN1), DFF, 32 * (r % 32), scr, lane);
            else if (r < I_DN + I_IN) { const int q = r - I_DN, n0 = 32 * (q % 112); transpose_item(a.w_in, DIN, n0 + (n0 >= 2048 ? 8 : 0), 64 * (q / 112), (bf16_t*)(a.ws + WS_WIN), DM, n0, scr, lane); }
            else { const int q = r - I_DN - I_IN; transpose_item(a.w_out, DM, 32 * (q % 32), 64 * (q / 32), (bf16_t*)(a.ws + WS_WOUT), DM, 32 * (q % 32), scr, lane); }
        }
    } else {
        const float* wu = grp == 0 ? a.w_up1 : a.w_up2; const float* wd = grp == 0 ? a.w_dn1 : a.w_dn2;
        bf16_t* du = (bf16_t*)(a.ws + (grp == 0 ? WS_WUP1 : WS_WUP2)); bf16_t* dd = (bf16_t*)(a.ws + (grp == 0 ? WS_WDN1 : WS_WDN2));
        for (int r = widx; r < I_UP + I_DN; r += nw) {
            if (r < I_UP) up_item(wu, du, r, scr, lane);
            else { const int q = r - I_UP; transpose_item(wd, DM, 32 * (q % 32), 64 * (q / 32), dd, DFF, 32 * (q % 32), scr, lane); }
        }
    }
}
DI void kvc_convert(const KArgs& a, int T, int NT) {
    bf16_t* KVC = (bf16_t*)(a.ws + WS_CST);
    for (int pc = T; pc < 32 * 512 * 128; pc += NT) {
        const int row = pc >> 7, q = pc & 127;
        const f32x4* src = (const f32x4*)((q < 64 ? a.cache_k : a.cache_v) + (size_t)row * 512 + (q & 63) * 8);
        const f32x4 v0 = src[0], v1 = src[1];
        u32x4 w; w.x = cvt_pk_bf16(v0[0], v0[1]); w.y = cvt_pk_bf16(v0[2], v0[3]); w.z = cvt_pk_bf16(v1[0], v1[1]); w.w = cvt_pk_bf16(v1[2], v1[3]);
        *(u32x4*)(KVC + (size_t)row * 1024 + q * 8) = w;
    }
}
DI void phase_prologue(const KArgs& a, LAS unsigned char* lds, int tid, int wave, int lane) {
    float* mod = (float*)(a.ws + WS_MOD);
    for (int cgi = blockIdx.x; cgi < NMOD / 64; cgi += gridDim.x) {
        LAS float* cs = (LAS float*)lds;
        for (int i = tid; i < 34 * 1024; i += 512) { const int r = i >> 10, k = i & 1023; const float c = r < 2 ? a.c_prompt[r * 1024 + k] : a.c_sample[(r - 2) * 1024 + k]; cs[i] = siluf_(c); }
        __syncthreads();
        float acc[34];
#pragma unroll
        for (int r = 0; r < 34; ++r) acc[r] = 0.f;
        const int col = cgi * 64 + lane;
        const float* wp = a.w_ada + (size_t)(wave * 128) * NMOD + col;
#define ADA_LD(dst, k4) do { const int kc_ = (k4) < 128 ? (k4) : 124; _Pragma("unroll") for (int i = 0; i < 4; ++i) dst[i] = wp[(size_t)(kc_ + i) * NMOD]; } while (0)
        float wa[4], wb[4], wc[4], wd[4];
        ADA_LD(wa, 0); ADA_LD(wb, 4); ADA_LD(wc, 8); ADA_LD(wd, 12);
        for (int kk = 0; kk < 128; kk += 4) {
            const int k = wave * 128 + kk;
            float w[4];
#pragma unroll
            for (int i = 0; i < 4; ++i) { w[i] = wa[i]; wa[i] = wb[i]; wb[i] = wc[i]; wc[i] = wd[i]; }
            ADA_LD(wd, kk + 16);
#pragma unroll
            for (int r = 0; r < 34; ++r) { const f32x4 c4 = *(const LAS f32x4*)(cs + r * 1024 + k); acc[r] += c4[0] * w[0] + c4[1] * w[1] + c4[2] * w[2] + c4[3] * w[3]; }
        }
#undef ADA_LD
        __syncthreads();
        LAS float* part = (LAS float*)lds;
#pragma unroll
        for (int r = 0; r < 34; ++r) part[(wave * 34 + r) * 64 + lane] = acc[r];
        __syncthreads();
        for (int o = tid; o < 34 * 64; o += 512) { const int r = o >> 6, l = o & 63; float s = a.b_ada[cgi * 64 + l];
#pragma unroll
            for (int w = 0; w < 8; ++w) s += part[(w * 34 + r) * 64 + l];
            mod[(size_t)r * NMOD + cgi * 64 + l] = s; }
        __syncthreads();
    }
    {
        bf16_t* PREVB = (bf16_t*)(a.ws + WS_PREVB);
        const int T = blockIdx.x * 512 + tid, NT = gridDim.x * 512;
        for (int i = T; i < 34 * 3 * 512; i += NT) {
            const int e = i * 2;
            unsigned w = 0u;
            if (e >= 2 * 3 * 1024) { const float* p = a.st_conv + (e - 2 * 3 * 1024); w = cvt_pk_bf16(p[0], p[1]); }
            *(unsigned*)(PREVB + e) = w;
        }
    }
    convert_group(a, 0, blockIdx.x * 8 + wave, gridDim.x * 8, lds, wave, lane);
}

template <bool GATES, int NSPLIT, bool P16>
DI void phase_norm(const KArgs& a, const float* xp, const bf16_t* xp16, const float* xs, float* xsw, const float* g, int shift_off, int scale_off, int pgate_off, float pcoef, int row_begin, LAS unsigned char* lds, int tid, int wave, int lane) {
    const float* mod = (const float*)(a.ws + WS_MOD);
    bf16_t* HN = (bf16_t*)(a.ws + WS_HN);
    float* gates = (float*)(a.ws + WS_GATES);
    f32x4 wgr[8][4];
    if (GATES) {
#pragma unroll
        for (int j = 0; j < 4; ++j)
#pragma unroll
            for (int i = 0; i < 4; ++i) {
                const f32x4* p = (const f32x4*)(a.w_in + (size_t)(4 * lane + 256 * j + i) * DIN + 2048);
                const f32x4 lo = p[0], hi = p[1];
                wgr[0][j][i] = lo[0]; wgr[1][j][i] = lo[1]; wgr[2][j][i] = lo[2]; wgr[3][j][i] = lo[3]; wgr[4][j][i] = hi[0]; wgr[5][j][i] = hi[1]; wgr[6][j][i] = hi[2]; wgr[7][j][i] = hi[3];
            }
    }
    const int gw = blockIdx.x * 8 + wave, NGW = gridDim.x * 8;
    for (int row = row_begin + gw; row < M; row += NGW) {
        f32x4 v[4]; float ss = 0.f;
        if (P16 && row < MP) {
            const u32x2* xr = (const u32x2*)(xp16 + (size_t)row * DM) + lane;
#pragma unroll
            for (int j = 0; j < 4; ++j) { const u32x2 w = xr[64 * j]; v[j] = (f32x4){bflo(w.x), bfhi(w.x), bflo(w.y), bfhi(w.y)}; }
        } else {
            const f32x4* xr = (const f32x4*)(row < MP ? xp + (size_t)row * DM : xs + (size_t)(row - MP) * DM) + lane;
#pragma unroll
            for (int j = 0; j < 4; ++j) v[j] = xr[64 * j];
        }
        const float* md = mod + (size_t)modrow(row) * NMOD;
        if (NSPLIT > 0 && row >= MP) {
            const float* part = (const float*)(a.ws + WS_UT) + (size_t)(row - MP) * DM;
#pragma unroll
            for (int j = 0; j < 4; ++j) {
                const int col = 4 * lane + 256 * j;
                f32x4 sum = *(const f32x4*)(part + col);
#pragma unroll
                for (int sp = 1; sp < NSPLIT; ++sp) sum += *(const f32x4*)(part + (size_t)sp * MS * DM + col);
                v[j] += (*(const f32x4*)(md + pgate_off + col) * pcoef) * sum;
                *(f32x4*)(xsw + (size_t)(row - MP) * DM + col) = v[j];
            }
        }
#pragma unroll
        for (int j = 0; j < 4; ++j) ss += (v[j][0] * v[j][0] + v[j][1] * v[j][1]) + (v[j][2] * v[j][2] + v[j][3] * v[j][3]);
        const float rstd = 1.0f / sqrtf(wave_sum(ss) * (1.0f / DM) + EPS);
        float gp[8];
#pragma unroll
        for (int c = 0; c < 8; ++c) gp[c] = 0.f;
#pragma unroll
        for (int j = 0; j < 4; ++j) {
            const int col = 4 * lane + 256 * j;
            const f32x4 g4 = *(const f32x4*)(g + col), sc = *(const f32x4*)(md + scale_off + col), sh = *(const f32x4*)(md + shift_off + col);
            const f32x4 h = (v[j] * rstd * g4) * (sc + 1.0f) + sh;
            u32x2 w; w.x = cvt_pk_bf16(h[0], h[1]); w.y = cvt_pk_bf16(h[2], h[3]);
            *(u32x2*)(HN + (size_t)row * DM + col) = w;
            if (GATES) {
#pragma unroll
                for (int c = 0; c < 8; ++c) { const f32x4 w4 = wgr[c][j]; gp[c] += (h[0] * w4[0] + h[1] * w4[1]) + (h[2] * w4[2] + h[3] * w4[3]); }
            }
        }
        if (GATES) {
            const bool b5 = (lane & 32) != 0, b4 = (lane & 16) != 0, b3 = (lane & 8) != 0;
            float k4[4], k2[2], k1;
#pragma unroll
            for (int i = 0; i < 4; ++i) { const float snd = b5 ? gp[i] : gp[i + 4]; k4[i] = (b5 ? gp[i + 4] : gp[i]) + __shfl_xor(snd, 32); }
#pragma unroll
            for (int i = 0; i < 2; ++i) { const float snd = b4 ? k4[i] : k4[i + 2]; k2[i] = (b4 ? k4[i + 2] : k4[i]) + __shfl_xor(snd, 16); }
            { const float snd = b3 ? k2[0] : k2[1]; k1 = (b3 ? k2[1] : k2[0]) + __shfl_xor(snd, 8); }
            k1 += __shfl_xor(k1, 4); k1 += __shfl_xor(k1, 2); k1 += __shfl_xor(k1, 1);
            const int c = (b5 ? 4 : 0) + (b4 ? 2 : 0) + (b3 ? 1 : 0);
            if ((lane & 7) == 0) gates[(size_t)row * 8 + c] = k1 + a.b_gates[c];
        }
    }
}
DI void phase_final_norm(const KArgs& a, const bf16_t* x16, const float* xs, int row_begin, int wave, int lane) {
    const int gw = blockIdx.x * 8 + wave, NGW = gridDim.x * 8;
    const float* mod = (const float*)(a.ws + WS_MOD);
    for (int row = row_begin + gw; row < M; row += NGW) {
        f32x4 v[4]; float ss = 0.f;
        if (row < MP) {
            const u32x2* xr = (const u32x2*)(x16 + (size_t)row * DM) + lane;
#pragma unroll
            for (int j = 0; j < 4; ++j) { const u32x2 w = xr[64 * j]; v[j] = (f32x4){bflo(w.x), bfhi(w.x), bflo(w.y), bfhi(w.y)}; }
        } else {
            const float* part = (const float*)(a.ws + WS_UT) + (size_t)(row - MP) * DM;
            const float* md = mod + (size_t)modrow(row) * NMOD + 8 * DM;
#pragma unroll
            for (int j = 0; j < 4; ++j) {
                const int col = 4 * lane + 256 * j;
                f32x4 sum = *(const f32x4*)(part + col);
#pragma unroll
                for (int sp = 1; sp < 4; ++sp) sum += *(const f32x4*)(part + (size_t)sp * MS * DM + col);
                v[j] = *(const f32x4*)(xs + (size_t)(row - MP) * DM + col) + (*(const f32x4*)(md + col) * 0.5f) * sum;
            }
        }
#pragma unroll
        for (int j = 0; j < 4; ++j) ss += (v[j][0] * v[j][0] + v[j][1] * v[j][1]) + (v[j][2] * v[j][2] + v[j][3] * v[j][3]);
        const float rstd = 1.0f / sqrtf(wave_sum(ss) * (1.0f / DM) + EPS);
        f32x4* yr = (f32x4*)(a.out + (size_t)row * DM) + lane;
#pragma unroll
        for (int j = 0; j < 4; ++j) { const f32x4 g4 = *(const f32x4*)(a.g_final + 4 * lane + 256 * j); yr[64 * j] = v[j] * rstd * g4; }
    }
}

constexpr int TP = 72;
DI void conv_load(const KArgs& a, const bf16_t* PROJ, int gc, int s0, int cch, unsigned (&u)[11]) {
    const int row0 = gc * 64;
    const bool special = gc >= 512 || (gc & 255) == 0;
    const bf16_t* PREVB = (const bf16_t*)(a.ws + WS_PREVB) + (size_t)(gc < 512 ? (gc >> 8) : 2 + (gc - 512)) * 3 * 1024;
#pragma unroll
    for (int r = 0; r < 11; ++r) {
        const int tp = s0 - 3 + r;
        const bf16_t* p = (tp < 0 && special) ? PREVB + (3 + tp) * 1024 + cch : PROJ + (size_t)(row0 + tp) * NPROJ + cch;
        u[r] = *(const unsigned*)p;
    }
}
typedef float f32x2v __attribute__((ext_vector_type(2)));
struct ConvW { f32x2v w[4]; f32x2v b; };
DI void convw_load(const KArgs& a, int cch, ConvW& W) {
#pragma unroll
    for (int j = 0; j < 4; ++j) W.w[j] = *(const f32x2v*)(a.conv_w + j * 1024 + cch);
    W.b = *(const f32x2v*)(a.conv_b + cch);
}
DI void conv_math(const ConvW& W, const unsigned (&u)[11], float (&o0)[8], float (&o1)[8]) {
#pragma unroll
    for (int j = 0; j < 8; ++j) {
        float x0 = W.b[0], x1 = W.b[1];
#pragma unroll
        for (int tap = 0; tap < 4; ++tap) { x0 += W.w[tap][0] * bflo(u[j + tap]); x1 += W.w[tap][1] * bfhi(u[j + tap]); }
        o0[j] = siluf_(x0); o1[j] = siluf_(x1);
    }
}
DI u32x4 pack8f(const float (&v)[8]) { u32x4 w; w.x = cvt_pk_bf16(v[0], v[1]); w.y = cvt_pk_bf16(v[2], v[3]); w.z = cvt_pk_bf16(v[4], v[5]); w.w = cvt_pk_bf16(v[6], v[7]); return w; }
DI void store_vT(const unsigned (&v)[8], int s0, LAS bf16_t* VT, int ch, int sw) {
    u32x4 lo, hi;
    lo.x = (v[0] & 0xffffu) | (v[1] << 16); lo.y = (v[2] & 0xffffu) | (v[3] << 16); lo.z = (v[4] & 0xffffu) | (v[5] << 16); lo.w = (v[6] & 0xffffu) | (v[7] << 16);
    hi.x = (v[0] >> 16) | (v[1] & 0xffff0000u); hi.y = (v[2] >> 16) | (v[3] & 0xffff0000u); hi.z = (v[4] >> 16) | (v[5] & 0xffff0000u); hi.w = (v[6] >> 16) | (v[7] & 0xffff0000u);
    *(LAS u32x4*)(VT + ch * TP + (s0 ^ sw)) = lo; *(LAS u32x4*)(VT + (ch + 1) * TP + (s0 ^ sw)) = hi;
}
DI float gate_cumsum(float fg, int lane) {
    float lf = fminf(fg, 0.f) - 0.6931471805599453f * __builtin_amdgcn_logf(1.0f + fexp(-fabsf(fg)));
#pragma unroll
    for (int o = 1; o < 64; o <<= 1) { const float t = __shfl_up(lf, o); if (lane >= o) lf += t; }
    return lf;
}
DI void store16_bf16(LAS bf16_t* p, const float (&o)[16]) {
    u32x4 w0, w1;
    w0.x = cvt_pk_bf16(o[0], o[1]); w0.y = cvt_pk_bf16(o[2], o[3]); w0.z = cvt_pk_bf16(o[4], o[5]); w0.w = cvt_pk_bf16(o[6], o[7]);
    w1.x = cvt_pk_bf16(o[8], o[9]); w1.y = cvt_pk_bf16(o[10], o[11]); w1.z = cvt_pk_bf16(o[12], o[13]); w1.w = cvt_pk_bf16(o[14], o[15]);
    *(LAS u32x4*)p = w0; *(LAS u32x4*)(p + 8) = w1;
}

struct ALoad { unsigned uk[11], v[8]; float fg, ig; };
DI void a_issue(const KArgs& a, int gc, int h, int wave, int lane, ALoad& L) {
    const bf16_t* PROJ = (const bf16_t*)(a.ws + WS_PROJ);
    const float* gates = (const float*)(a.ws + WS_GATES);
    const int row0 = gc * 64, s0 = 8 * wave, ch = 2 * lane;
    conv_load(a, PROJ, gc, s0, PK + h * 128 + ch, L.uk);
#pragma unroll
    for (int j = 0; j < 8; ++j) L.v[j] = *(const unsigned*)(PROJ + (size_t)(row0 + s0 + j) * NPROJ + PV + h * 128 + ch);
    L.fg = gates[(size_t)(row0 + lane) * 8 + 4 + h]; L.ig = gates[(size_t)(row0 + lane) * 8 + h];
}
DI void mlstmA_loop(const KArgs& a, LAS unsigned char* lds, int jbeg, int jend, int tid, int wave, int lane) {
    float* chk = (float*)(a.ws + WS_CHK);
    bf16_t* UT = (bf16_t*)(a.ws + WS_UT);
    const int fr = lane & 15, g = lane >> 4;
    int j = jbeg;
    if (j >= jend) return;
#define A_GC(jx) ((((jx) % NGC) * 33) % NGC)
    ALoad L; a_issue(a, A_GC(j), j / NGC, wave, lane, L);
    ConvW Wk; int hw = j / NGC; convw_load(a, PK + hw * 128 + 2 * lane, Wk);
    for (; j < jend; ++j) {
        const int gc = A_GC(j), h = j / NGC, idx = gc * 4 + h;
        LAS bf16_t* KgT = (LAS bf16_t*)(lds + ((j - jbeg) & 1) * (2 * 128 * TP * 2));
        LAS bf16_t* VT = KgT + 128 * TP;
        if (h != hw) { hw = h; convw_load(a, PK + hw * 128 + 2 * lane, Wk); }
        const float b = gate_cumsum(L.fg, lane);
        const float bend = __shfl(b, 63);
        const float logg = bend - b + L.ig;
        const float mloc = wave_max(logg);
        const float gv = fexp(logg - mloc);
        if (tid == 0) { chk[idx] = bend; chk[NGC * 4 + idx] = mloc; }
        {
            const int s0 = 8 * wave, ch = 2 * lane, sw = 8 * (ch >> 4);
            float k0[8], k1[8]; conv_math(Wk, L.uk, k0, k1);
#pragma unroll
            for (int j = 0; j < 8; ++j) { const float gs = __shfl(gv, s0 + j) * 0.08838834764831845f; k0[j] *= gs; k1[j] *= gs; }
            *(LAS u32x4*)(KgT + ch * TP + (s0 ^ sw)) = pack8f(k0); *(LAS u32x4*)(KgT + (ch + 1) * TP + (s0 ^ sw)) = pack8f(k1);
            store_vT(L.v, s0, VT, ch, sw);
        }
        __syncthreads();
        { const int jn = j + 1 < jend ? j + 1 : j; a_issue(a, A_GC(jn), jn / NGC, wave, lane, L); }
        bf16x8 aF[2];
#pragma unroll
        for (int ks = 0; ks < 2; ++ks) aF[ks] = *(const LAS bf16x8*)(KgT + (16 * wave + fr) * TP + ((32 * ks + 8 * g) ^ (8 * wave)));
        bf16_t* ub = UT + (size_t)idx * 129 * 128 + 16 * wave + 4 * g;
        const bool smp = gc >= 512; const int sh = (gc - 512) * 4 + h, dk0 = 16 * wave + 4 * g;
        float dec = 0.f, scl = 0.f;
        bf16_t* cb = (bf16_t*)(a.ws + WS_CST) + (size_t)idx * 129 * 128 + dk0;
        if (smp) {
            const float m_in = a.st_m[sh], mn = fmaxf(bend + m_in, mloc);
            dec = fexp(bend + m_in - mn); scl = fexp(mloc - mn);
            if (tid == 0) { chk[2 * NGC * 4 + idx] = m_in; a.out[OFF_M_S + sh] = mn; }
        }
#pragma unroll
        for (int jt = 0; jt < 8; ++jt) {
            f32x4 acc = {0.f, 0.f, 0.f, 0.f};
#pragma unroll
            for (int ks = 0; ks < 2; ++ks) { const bf16x8 bF = *(const LAS bf16x8*)(VT + (16 * jt + fr) * TP + ((32 * ks + 8 * g) ^ (8 * jt))); acc = MFMA16(aF[ks], bF, acc); }
            if (!smp) {
                u32x2 w; w.x = cvt_pk_bf16(acc[0], acc[1]); w.y = cvt_pk_bf16(acc[2], acc[3]);
                *(u32x2*)(ub + (size_t)(16 * jt + fr) * 128) = w;
            } else {
                const size_t eo = ((size_t)sh * 128 + dk0) * 128 + 16 * jt + fr;
                const float* ci = a.st_C + eo; float* co = a.out + OFF_C_S + eo;
                const float c0 = ci[0], c1 = ci[128], c2 = ci[256], c3 = ci[384];
                co[0] = dec * c0 + scl * acc[0]; co[128] = dec * c1 + scl * acc[1]; co[256] = dec * c2 + scl * acc[2]; co[384] = dec * c3 + scl * acc[3];
                u32x2 w; w.x = cvt_pk_bf16(c0, c1); w.y = cvt_pk_bf16(c2, c3);
                *(u32x2*)(cb + (size_t)(16 * jt + fr) * 128) = w;
            }
        }
        {
            const short one = fr == 0 ? (short)0x3F80 : (short)0;
            const bf16x8 bF = {one, one, one, one, one, one, one, one};
            f32x4 acc = {0.f, 0.f, 0.f, 0.f};
#pragma unroll
            for (int ks = 0; ks < 2; ++ks) acc = MFMA16(aF[ks], bF, acc);
            if (fr == 0) {
                if (!smp) { u32x2 w; w.x = cvt_pk_bf16(acc[0], acc[1]); w.y = cvt_pk_bf16(acc[2], acc[3]); *(u32x2*)(ub + (size_t)128 * 128) = w; }
                else {
                    const f32x4 n4 = *(const f32x4*)(a.st_n + (size_t)sh * 128 + dk0);
                    *(f32x4*)(a.out + OFF_N_S + (size_t)sh * 128 + dk0) = n4 * dec + acc * scl;
                    u32x2 w; w.x = cvt_pk_bf16(n4[0], n4[1]); w.y = cvt_pk_bf16(n4[2], n4[3]); *(u32x2*)(cb + (size_t)128 * 128) = w;
                }
            }
        }
    }
    __syncthreads();
}

DI bf16x8 pack8(const f32x4 lo, const f32x4 hi) {
    u32x4 w; w.x = cvt_pk_bf16(lo[0], lo[1]); w.y = cvt_pk_bf16(lo[2], lo[3]); w.z = cvt_pk_bf16(hi[0], hi[1]); w.w = cvt_pk_bf16(hi[2], hi[3]);
    return __builtin_bit_cast(bf16x8, w);
}
constexpr int VP32 = 40;
constexpr int ATT_WAVE_LDS = 64 * 64 * 2 + 64 * VP32 * 2;
DI float max3f(float a, float b, float c) { float r; asm("v_max3_f32 %0, %1, %2, %3" : "=v"(r) : "v"(a), "v"(b), "v"(c)); return r; }
DI void attn_item(const KArgs& a, int gc, LAS unsigned char* lds, int wave, int lane) {
    const bf16_t* PROJ = (const bf16_t*)(a.ws + WS_PROJ);
    const bf16_t* KVC = (const bf16_t*)(a.ws + WS_CST);
    bf16_t* MIX = (bf16_t*)(a.ws + WS_HN);
    const int h = wave, fr = lane & 15, g = lane >> 4, row0 = gc * 64;
    const bool is_s = gc >= 512; const int sidx = gc - 512, c = gc & 255;
    LAS unsigned char* Qs = lds + wave * ATT_WAVE_LDS;
    LAS bf16_t* VT = (LAS bf16_t*)(lds + wave * ATT_WAVE_LDS + 8192);
    const LAS float* tab = (const LAS float*)(lds + TAB_OFF) + h * 256;
#pragma unroll
    for (int i8 = 0; i8 < 8; ++i8) {
        const int t = (lane >> 3) + 8 * i8, cq = lane & 7;
        const u32x4 w = *(const u32x4*)(PROJ + (size_t)(row0 + t) * NPROJ + PAQ + 64 * h + 8 * cq);
        *(LAS u32x4*)(Qs + t * 128 + ((cq ^ (t & 7)) << 4)) = w;
    }
    float mrun[4], lrun[4]; f32x4 oacc[4][4];
#pragma unroll
    for (int tt = 0; tt < 4; ++tt) { mrun[tt] = -INFINITY; lrun[tt] = 0.f;
#pragma unroll
        for (int dt = 0; dt < 4; ++dt) oacc[dt][tt] = (f32x4){0.f, 0.f, 0.f, 0.f}; }
    const int kt0 = is_s ? 0 : (c >= 8 ? 0 : 8 - c);
#define ATT_SRC(j2_, kp_, vp_, pitch_) do { const int kt_ = (j2_) >> 1, hf_ = (j2_) & 1; if (is_s && kt_ < 8) { kp_ = KVC + (size_t)(sidx * 512 + 64 * kt_ + 32 * hf_) * 1024 + 64 * h; vp_ = kp_ + 512; pitch_ = 1024; } \
        else { const size_t kr_ = (size_t)(row0 - (8 - kt_) * 64 + 32 * hf_); kp_ = PROJ + kr_ * NPROJ + PAK + 64 * h; vp_ = PROJ + kr_ * NPROJ + PAV + 64 * h; pitch_ = NPROJ; } } while (0)
#define ATT_LOAD(KF, VR, kp_, vp_, pitch_) do { const unsigned koff_ = (unsigned)(fr * (pitch_) + 8 * g) * 2u, voff_ = (unsigned)((lane >> 3) * (pitch_) + 8 * (lane & 7)) * 2u; \
        _Pragma("unroll") for (int it = 0; it < 2; ++it) _Pragma("unroll") for (int ks = 0; ks < 2; ++ks) KF[it][ks] = *(const bf16x8*)((const char*)(kp_ + (size_t)(16 * it) * (pitch_) + 32 * ks) + koff_); \
        _Pragma("unroll") for (int jj = 0; jj < 4; ++jj) VR[jj] = *(const u32x4*)((const char*)(vp_ + (size_t)(8 * jj) * (pitch_)) + voff_); } while (0)
    bf16x8 kf[2][2]; u32x4 vr[4];
    { const bf16_t* kp; const bf16_t* vp; int pitch; ATT_SRC(2 * kt0, kp, vp, pitch); ATT_LOAD(kf, vr, kp, vp, pitch); }
    const float bias_far = tab[191];
    for (int j2 = 2 * kt0; j2 < 18; ++j2) {
#pragma unroll
        for (int jj = 0; jj < 4; ++jj) {
            const int key = (lane >> 3) + 8 * jj, p = lane & 7, ksw = key ^ (8 * (p & 3));
            const unsigned ww[4] = {vr[jj].x, vr[jj].y, vr[jj].z, vr[jj].w};
#pragma unroll
            for (int e = 0; e < 4; ++e) { VT[(8 * p + 2 * e) * VP32 + ksw] = (bf16_t)(ww[e] & 0xffffu); VT[(8 * p + 2 * e + 1) * VP32 + ksw] = (bf16_t)(ww[e] >> 16); }
        }
        bf16x8 kn[2][2];
        { const int jn = j2 < 17 ? j2 + 1 : j2; const bf16_t* kp; const bf16_t* vp; int pitch; ATT_SRC(jn, kp, vp, pitch); ATT_LOAD(kn, vr, kp, vp, pitch); }
        const int kt = j2 >> 1;
        const int relb = 64 * (8 - kt) - 32 * (j2 & 1);
        const LAS float* tb = tab + (fr - 4 * g + relb + 63 - 64);
        bf16x8 vA[4];
#pragma unroll
        for (int dt = 0; dt < 4; ++dt) {
            const int sw = 8 * ((2 * dt + (fr >> 3)) & 3);
            const LAS bf16_t* vrow = VT + (16 * dt + fr) * VP32;
            const s16x4 lo = *(const LAS s16x4*)(vrow + ((4 * g) ^ sw)), hi = *(const LAS s16x4*)(vrow + ((16 + 4 * g) ^ sw));
            vA[dt] = __builtin_shufflevector(lo, hi, 0, 1, 2, 3, 4, 5, 6, 7);
        }
        f32x4 sacc[4][2];
#pragma unroll
        for (int tt = 0; tt < 4; ++tt) {
            const int t = 16 * tt + fr;
            bf16x8 qB[2];
#pragma unroll
            for (int ks = 0; ks < 2; ++ks) qB[ks] = *(const LAS bf16x8*)(Qs + t * 128 + (((4 * ks + g) ^ (t & 7)) << 4));
#pragma unroll
            for (int it = 0; it < 2; ++it) { sacc[tt][it] = (f32x4){0.f, 0.f, 0.f, 0.f};
#pragma unroll
                for (int ks = 0; ks < 2; ++ks) sacc[tt][it] = MFMA16(kf[it][ks], qB[ks], sacc[tt][it]); }
        }
        if (kt <= 5) {
#pragma unroll
            for (int tt = 0; tt < 4; ++tt)
#pragma unroll
                for (int it = 0; it < 2; ++it)
#pragma unroll
                    for (int r = 0; r < 4; ++r) sacc[tt][it][r] = __builtin_fmaf(sacc[tt][it][r], 0.125f * LOG2E, bias_far);
        } else {
#pragma unroll
            for (int tt = 0; tt < 4; ++tt)
#pragma unroll
                for (int it = 0; it < 2; ++it)
#pragma unroll
                    for (int r = 0; r < 4; ++r) sacc[tt][it][r] = __builtin_fmaf(sacc[tt][it][r], 0.125f * LOG2E, tb[16 * (tt - it) - r + 64]);
        }
        float tmax[4]; bool need = false;
#pragma unroll
        for (int tt = 0; tt < 4; ++tt) {
            float m = max3f(sacc[tt][0][0], sacc[tt][0][1], sacc[tt][0][2]);
            m = max3f(m, sacc[tt][0][3], sacc[tt][1][0]);
            m = max3f(m, sacc[tt][1][1], sacc[tt][1][2]);
            tmax[tt] = __builtin_fmaxf(m, sacc[tt][1][3]);
            need = need || (tmax[tt] > mrun[tt] + 8.0f);
        }
        if (__any(need)) {
#pragma unroll
            for (int tt = 0; tt < 4; ++tt) {
                float m = tmax[tt]; m = __builtin_fmaxf(m, __shfl_xor(m, 16)); m = __builtin_fmaxf(m, __shfl_xor(m, 32));
                const float mnew = __builtin_fmaxf(mrun[tt], m);
                const float alpha = fexp2(mrun[tt] - mnew); lrun[tt] *= alpha; mrun[tt] = mnew;
#pragma unroll
                for (int dt = 0; dt < 4; ++dt) oacc[dt][tt] = oacc[dt][tt] * alpha;
            }
        }
#pragma unroll
        for (int tt = 0; tt < 4; ++tt) {
            const float mref = mrun[tt];
            float lsum = 0.f;
#pragma unroll
            for (int it = 0; it < 2; ++it)
#pragma unroll
                for (int r = 0; r < 4; ++r) { const float p = fexp2(sacc[tt][it][r] - mref); sacc[tt][it][r] = p; lsum += p; }
            lrun[tt] += lsum;
            const bf16x8 pB = pack8(sacc[tt][0], sacc[tt][1]);
#pragma unroll
            for (int dt = 0; dt < 4; ++dt) oacc[dt][tt] = MFMA16(vA[dt], pB, oacc[dt][tt]);
        }
#pragma unroll
        for (int it = 0; it < 2; ++it)
#pragma unroll
            for (int ks = 0; ks < 2; ++ks) kf[it][ks] = kn[it][ks];
    }
#undef ATT_SRC
#undef ATT_LOAD
#pragma unroll
    for (int tt = 0; tt < 4; ++tt) {
        float l = lrun[tt]; l += __shfl_xor(l, 16); l += __shfl_xor(l, 32);
        const float inv = 1.0f / l;
#pragma unroll
        for (int dt = 0; dt < 4; ++dt) {
            const f32x4 o = oacc[dt][tt] * inv;
            u32x2 w; w.x = cvt_pk_bf16(o[0], o[1]); w.y = cvt_pk_bf16(o[2], o[3]);
            *(u32x2*)(MIX + (size_t)(row0 + 16 * tt + fr) * DM + 512 + 64 * h + 16 * dt + 4 * g) = w;
        }
    }
}
#ifndef ATT_N7
#define ATT_N7 191
#endif
DI void phase_mixA(const KArgs& a, LAS unsigned char* lds, int tid, int wave, int lane) {
    LAS float* tab = (LAS float*)(lds + TAB_OFF);
    for (int i = tid; i < 8 * 256; i += 512) { const int e = i & 255; tab[i] = a.rel_tab[(i >> 8) * 192 + (e > 191 ? 191 : e)] * LOG2E; }
    __syncthreads();
    for (int it = ATT_N7 + blockIdx.x; it < NGC; it += gridDim.x) attn_item(a, it, lds, wave, lane);
    __syncthreads();
    int jbeg, jend; const int b = (int)blockIdx.x, Gd = (int)gridDim.x;
    if (Gd == 256 && ATT_N7 == 191) {
        const int n2 = (NGC - ATT_N7) - 256;
        constexpr int NLO = 4, NHI = 11; const int extra = NGC * 4 - (n2 * NLO + (256 - n2) * NHI);
        if (b < n2) { jbeg = NLO * b; jend = jbeg + NLO; }
        else { const int q = b - n2; jbeg = n2 * NLO + q * NHI + (q < extra ? q : extra); jend = jbeg + NHI + (q < extra ? 1 : 0); }
    } else { const int per = (NGC * 4 + Gd - 1) / Gd; jbeg = b * per; jend = jbeg + per < NGC * 4 ? jbeg + per : NGC * 4; }
    mlstmA_loop(a, lds, jbeg, jend, tid, wave, lane);
}

DI void phase_scan(const KArgs& a, int tid) {
    const bf16_t* UT = (const bf16_t*)(a.ws + WS_UT);
    bf16_t* CST = (bf16_t*)(a.ws + WS_CST);
    float* chk = (float*)(a.ws + WS_CHK);
    const float* bend = chk; const float* mloc = chk + NGC * 4; float* mst = chk + 2 * NGC * 4;
    constexpr int E4 = 129 * 128 / 4, NPI = 8 * E4;
    const int T = blockIdx.x * 512 + tid, NT = gridDim.x * 512;
    for (int it = T; it < NPI; it += NT) {
        const int bh = it / E4, e4 = it % E4, bb = bh >> 2, h = bh & 3;
        float c0 = 0.f, c1 = 0.f, c2 = 0.f, c3 = 0.f, m = 0.f;
        const size_t estride = (size_t)4 * 129 * 128;
        const size_t e0 = ((size_t)(bb * 256) * 4 + h) * 129 * 128 + (size_t)e4 * 4;
        const int i0 = bb * 256 * 4 + h;
        u32x2 ub[16]; float be[16], ml[16];
#pragma unroll
        for (int j = 0; j < 16; ++j) { ub[j] = *(const u32x2*)(UT + e0 + (size_t)j * estride); be[j] = bend[i0 + 4 * j]; ml[j] = mloc[i0 + 4 * j]; }
        for (int grp = 0; grp < 16; ++grp) {
            u32x2 un[16]; float ben[16], mln[16];
            const int cn = (grp + 1 < 16 ? grp + 1 : grp) * 16;
#pragma unroll
            for (int j = 0; j < 16; ++j) { un[j] = *(const u32x2*)(UT + e0 + (size_t)(cn + j) * estride); ben[j] = bend[i0 + 4 * (cn + j)]; mln[j] = mloc[i0 + 4 * (cn + j)]; }
#pragma unroll
            for (int j = 0; j < 16; ++j) {
                const int cc = grp * 16 + j;
                u32x2 w; w.x = cvt_pk_bf16(c0, c1); w.y = cvt_pk_bf16(c2, c3);
                *(u32x2*)(CST + e0 + (size_t)cc * estride) = w;
                if (e4 == 0) mst[i0 + 4 * cc] = m;
                const float mn = fmaxf(be[j] + m, ml[j]);
                const float dec = fexp(be[j] + m - mn), sc = fexp(ml[j] - mn);
                c0 = dec * c0 + sc * bflo(ub[j].x); c1 = dec * c1 + sc * bfhi(ub[j].x); c2 = dec * c2 + sc * bflo(ub[j].y); c3 = dec * c3 + sc * bfhi(ub[j].y);
                m = mn;
            }
#pragma unroll
            for (int j = 0; j < 16; ++j) { ub[j] = un[j]; be[j] = ben[j]; ml[j] = mln[j]; }
        }
        const int e = e4 * 4, dv = e >> 7, dk = e & 127;
        if (dv < 128) { float* o = a.out + OFF_C_P + ((size_t)bh * 128 + dk) * 128 + dv; o[0] = c0; o[128] = c1; o[256] = c2; o[384] = c3; }
        else { float* o = a.out + OFF_N_P + (size_t)bh * 128 + dk; o[0] = c0; o[1] = c1; o[2] = c2; o[3] = c3; }
        if (e4 == 0) a.out[OFF_M_P + bh] = m;
    }
}

constexpr int QP = 136;
constexpr int C_QS = 0, C_KS = C_QS + 64 * QP * 2, C_VT = C_KS + 64 * QP * 2, C_CT = C_VT + 144 * TP * 2, C_SS = C_CT + 144 * QP * 2, C_END = C_SS + 512;
static_assert(C_END <= TAB_OFF, "phase C LDS");
struct CLoad { unsigned uq[11], uk[11], v[8]; u32x4 ct[5]; u32x2 mo[4]; float fg, ig, mprev; };
DI void c_issue(const KArgs& a, int gc, int h, int tid, int wave, int lane, CLoad& L) {
    const bf16_t* PROJ = (const bf16_t*)(a.ws + WS_PROJ);
    const float* gates = (const float*)(a.ws + WS_GATES);
    const float* mst = (const float*)(a.ws + WS_CHK) + 2 * NGC * 4;
    const bf16_t* CST = (const bf16_t*)(a.ws + WS_CST);
    const int row0 = gc * 64, idx = gc * 4 + h, s0 = 8 * wave, ch = 2 * lane, fr = lane & 15, g = lane >> 4;
    conv_load(a, PROJ, gc, s0, PQ + h * 128 + ch, L.uq);
    conv_load(a, PROJ, gc, s0, PK + h * 128 + ch, L.uk);
#pragma unroll
    for (int j = 0; j < 8; ++j) L.v[j] = *(const unsigned*)(PROJ + (size_t)(row0 + s0 + j) * NPROJ + PV + h * 128 + ch);
#pragma unroll
    for (int i = 0; i < 5; ++i) { const int p8 = tid + 512 * i; int dv = p8 >> 4; dv = dv > 128 ? 128 : dv; L.ct[i] = *(const u32x4*)(CST + ((size_t)idx * 129 + dv) * 128 + (p8 & 15) * 8); }
    const int t = 16 * (wave & 3) + fr, dh = wave >> 2;
#pragma unroll
    for (int q = 0; q < 4; ++q) L.mo[q] = *(const u32x2*)(PROJ + (size_t)(row0 + t) * NPROJ + PO + h * 128 + 16 * (4 * dh + q) + 4 * g);
    L.fg = gates[(size_t)(row0 + lane) * 8 + 4 + h]; L.ig = gates[(size_t)(row0 + lane) * 8 + h]; L.mprev = mst[idx];
}
DI void phase_mixC(const KArgs& a, LAS unsigned char* lds, int tid, int wave, int lane) {
    bf16_t* MIX = (bf16_t*)(a.ws + WS_HN);
    LAS bf16_t* Qs = (LAS bf16_t*)(lds + C_QS); LAS bf16_t* Ks = (LAS bf16_t*)(lds + C_KS); LAS bf16_t* VT = (LAS bf16_t*)(lds + C_VT); LAS bf16_t* CT = (LAS bf16_t*)(lds + C_CT);
    LAS float* SS = (LAS float*)(lds + C_SS);
    const int fr = lane & 15, g = lane >> 4, G = gridDim.x;
    for (int e = tid; e < 16 * 64; e += 512) VT[(128 + (e >> 6)) * TP + (e & 63)] = (e >> 6) == 0 ? (bf16_t)0x3F80 : (bf16_t)0;
    for (int p8 = tid; p8 < 15 * 16; p8 += 512) *(LAS u32x4*)(CT + (129 + (p8 >> 4)) * QP + (p8 & 15) * 8) = (u32x4){0u, 0u, 0u, 0u};
    __syncthreads();
    int it = blockIdx.x;
    if (it >= NGC * 4) return;
    CLoad L; c_issue(a, it >> 2, it & 3, tid, wave, lane, L);
    ConvW Wq, Wk; int hw = it & 3;
#define C_HLOAD() do { convw_load(a, PQ + hw * 128 + 2 * lane, Wq); convw_load(a, PK + hw * 128 + 2 * lane, Wk); } while (0)
    C_HLOAD();
    for (; it < NGC * 4; it += G) {
        const int gc = it >> 2, h = it & 3, row0 = gc * 64;
        if (h != hw) { hw = h; C_HLOAD(); }
        const float b = gate_cumsum(L.fg, lane);
        const float mprev = L.mprev;
        const float x = L.ig - b;
        float pm = x;
#pragma unroll
        for (int o = 1; o < 64; o <<= 1) { const float t = __shfl_up(pm, o); if (lane >= o) pm = fmaxf(pm, t); }
        const float mt = b + fmaxf(mprev, pm);
        const float winter = fexp(b + mprev - mt), bm = b - mt, em = fexp(-mt);
        {
            const int s0 = 8 * wave, ch = 2 * lane, sw = 8 * (ch >> 4);
            float q0[8], q1[8]; conv_math(Wq, L.uq, q0, q1);
#pragma unroll
            for (int j = 0; j < 8; ++j) *(LAS unsigned*)(Qs + (s0 + j) * QP + ch) = cvt_pk_bf16(q0[j], q1[j]);
            float k0[8], k1[8]; conv_math(Wk, L.uk, k0, k1);
#pragma unroll
            for (int j = 0; j < 8; ++j) *(LAS unsigned*)(Ks + (s0 + j) * QP + ch) = cvt_pk_bf16(k0[j] * 0.08838834764831845f, k1[j] * 0.08838834764831845f);
            store_vT(L.v, s0, VT, ch, sw);
#pragma unroll
            for (int i = 0; i < 5; ++i) { const int p8 = tid + 512 * i; if (p8 < 129 * 16) *(LAS u32x4*)(CT + (p8 >> 4) * QP + (p8 & 15) * 8) = L.ct[i]; }
        }
        u32x2 mo[4];
#pragma unroll
        for (int q = 0; q < 4; ++q) mo[q] = L.mo[q];
        __syncthreads();
        { const int itn = it + G < NGC * 4 ? it + G : it; c_issue(a, itn >> 2, itn & 3, tid, wave, lane, L); }
        const int tt = wave & 3, dh = wave >> 2;
        bf16x8 qB[4];
#pragma unroll
        for (int ks = 0; ks < 4; ++ks) qB[ks] = *(const LAS bf16x8*)(Qs + (16 * tt + fr) * QP + 32 * ks + 8 * g);
        f32x4 sacc[4];
#pragma unroll
        for (int i4 = 0; i4 < 4; ++i4) { sacc[i4] = (f32x4){0.f, 0.f, 0.f, 0.f};
#pragma unroll
            for (int ks = 0; ks < 4; ++ks) { const bf16x8 kA = *(const LAS bf16x8*)(Ks + (16 * i4 + fr) * QP + 32 * ks + 8 * g); sacc[i4] = MFMA16(kA, qB[ks], sacc[i4]); } }
        const int t = 16 * tt + fr;
        const float bm_t = __shfl(bm, t), wi_t = __shfl(winter, t), em_t = __shfl(em, t);
#pragma unroll
        for (int i4 = 0; i4 < 4; ++i4)
#pragma unroll
            for (int r = 0; r < 4; ++r) {
                const int s_ = 16 * i4 + 4 * g + r;
                const float xs = __shfl(x, s_);
                const float w = (s_ <= t) ? fexp(bm_t + xs) : 0.f;
                sacc[i4][r] *= w;
            }
        bf16x8 pB[2];
#pragma unroll
        for (int k2 = 0; k2 < 2; ++k2) pB[k2] = pack8(sacc[2 * k2], sacc[2 * k2 + 1]);
        f32x4 res[5];
#pragma unroll
        for (int q = 0; q < 5; ++q) {
            const int dvt = q < 4 ? 4 * dh + q : 8;
            f32x4 a1 = {0.f, 0.f, 0.f, 0.f}, a2 = {0.f, 0.f, 0.f, 0.f};
#pragma unroll
            for (int ks = 0; ks < 4; ++ks) { const bf16x8 cA = *(const LAS bf16x8*)(CT + (16 * dvt + fr) * QP + 32 * ks + 8 * g); a1 = MFMA16(cA, qB[ks], a1); }
#pragma unroll
            for (int k2 = 0; k2 < 2; ++k2) {
                const LAS bf16_t* vp = VT + (16 * dvt + fr) * TP; const int sw = 8 * (dvt & 7);
                const s16x4 lo = *(const LAS s16x4*)(vp + ((32 * k2 + 4 * g) ^ sw)), hi = *(const LAS s16x4*)(vp + ((32 * k2 + 16 + 4 * g) ^ sw));
                const bf16x8 vA = __builtin_shufflevector(lo, hi, 0, 1, 2, 3, 4, 5, 6, 7);
                a2 = MFMA16(vA, pB[k2], a2);
            }
            res[q] = a1 * wi_t + a2;
        }
        const float den = __shfl(res[4][0], fr);
        const float inv = 1.0f / fmaxf(fabsf(den), em_t);
        float ssq = 0.f;
#pragma unroll
        for (int q = 0; q < 4; ++q)
#pragma unroll
            for (int r = 0; r < 4; ++r) { const float hv = res[q][r] * inv; res[q][r] = hv; ssq += hv * hv; }
        ssq += __shfl_xor(ssq, 16); ssq += __shfl_xor(ssq, 32);
        f32x4 gm[4];
#pragma unroll
        for (int q = 0; q < 4; ++q) gm[q] = *(const f32x4*)(a.g_mlstm + h * 128 + 16 * (4 * dh + q) + 4 * g);
        if (g == 0) SS[dh * 64 + t] = ssq;
        __syncthreads();
        const float rs = 1.0f / sqrtf((SS[t] + SS[64 + t]) * (1.0f / 128.0f) + EPS);
#pragma unroll
        for (int q = 0; q < 4; ++q) {
            const int col = h * 128 + 16 * (4 * dh + q) + 4 * g;
            const float o0 = sigmoidf_(bflo(mo[q].x)) * res[q][0] * rs * gm[q][0], o1 = sigmoidf_(bfhi(mo[q].x)) * res[q][1] * rs * gm[q][1];
            const float o2 = sigmoidf_(bflo(mo[q].y)) * res[q][2] * rs * gm[q][2], o3 = sigmoidf_(bfhi(mo[q].y)) * res[q][3] * rs * gm[q][3];
            u32x2 w; w.x = cvt_pk_bf16(o0, o1); w.y = cvt_pk_bf16(o2, o3);
            *(u32x2*)(MIX + (size_t)(row0 + t) * DM + col) = w;
        }
        __syncthreads();
    }
#undef C_HLOAD
}

#define XB_TMO      128
#define XB_XCNT(j)  (256  + 64 * (j))
#define XB_XSUB(j)  (1280 + 64 * (j))
#define XB_XGEN(j)  (2304 + 64 * (j))
#define XB_TOP      3328
#define XB_TOPGEN   3392
#define XCD_BAR_WORDS 3456
#define XB_SPIN_CAP (1u << 18)

__device__ __forceinline__ unsigned xb_ld(unsigned* p)              { return __hip_atomic_load(p, __ATOMIC_RELAXED, __HIP_MEMORY_SCOPE_AGENT); }
__device__ __forceinline__ unsigned xb_add(unsigned* p, unsigned v) { return __hip_atomic_fetch_add(p, v, __ATOMIC_RELAXED, __HIP_MEMORY_SCOPE_AGENT); }
__device__ __forceinline__ unsigned xb_xcc_id() { return (unsigned)__builtin_amdgcn_s_getreg((3 << 11) | 20) & 0xFu; }
#define XB_SPIN(cond, bar) do { unsigned _sp = 0; while (cond) { __builtin_amdgcn_s_sleep(1); \
    if ((++_sp & 255u) == 0u) { if (xb_ld(&(bar)[XB_TMO])) break; if (_sp > XB_SPIN_CAP) { atomicAdd(&(bar)[XB_TMO], 1u); break; } } } } while (0)

struct XcdBarrier {
    unsigned* bar; unsigned x;
    volatile LAS unsigned* st;
};

__device__ __forceinline__ XcdBarrier xcd_barrier_post(unsigned* bar, volatile LAS unsigned* st) {
    XcdBarrier b; b.bar = bar; b.x = xb_xcc_id(); b.st = st;
    if (threadIdx.x == 0) (void)xb_add(&bar[XB_XCNT(b.x)], 1u);
    return b;
}
__device__ __forceinline__ void xcd_barrier_complete(unsigned* bar, unsigned x, unsigned& nloc, unsigned& nx) {
    const unsigned G = gridDim.x * gridDim.y * gridDim.z;
    unsigned sum, cnt, mine, sp = 0u;
    for (;;) {
        sum = 0u; cnt = 0u; mine = 0u;
#pragma unroll
        for (unsigned j = 0; j < 16; ++j) { const unsigned c = xb_ld(&bar[XB_XCNT(j)]); sum += c; cnt += (c > 0u) ? 1u : 0u; mine = (j == x) ? c : mine; }
        if (sum == G) break;
        __builtin_amdgcn_s_sleep(1);
        if ((++sp & 255u) == 0u) { if (xb_ld(&bar[XB_TMO])) break; if (sp > XB_SPIN_CAP) { atomicAdd(&bar[XB_TMO], 1u); break; } }
    }
    nloc = mine > 0u ? mine : 1u; nx = cnt > 0u ? cnt : 1u;
}

__device__ __forceinline__ void xcd_barrier(const XcdBarrier& b) {
    asm volatile("s_waitcnt vmcnt(0)" ::: "memory");
    __syncthreads();
    if (threadIdx.x == 0) {
        unsigned* bar = b.bar;
        __builtin_amdgcn_s_waitcnt(0);
        unsigned nloc = b.st[0], nx = b.st[1];
        if (nloc == 0u) { xcd_barrier_complete(bar, b.x, nloc, nx); b.st[0] = nloc; b.st[1] = nx; }
        const unsigned old = xb_add(&bar[XB_XSUB(b.x)], 1u);
        const unsigned gen = old / nloc;
        if (old + 1u == (gen + 1u) * nloc) {
            __builtin_amdgcn_fence(__ATOMIC_RELEASE, "agent");
            asm volatile("s_waitcnt vmcnt(0)" ::: "memory");
            const unsigned og = xb_add(&bar[XB_TOP], 1u);
            const unsigned tg = og / nx;
            if (og + 1u == (tg + 1u) * nx) xb_add(&bar[XB_TOPGEN], 1u);
            else XB_SPIN(xb_ld(&bar[XB_TOPGEN]) == tg, bar);
            __builtin_amdgcn_fence(__ATOMIC_ACQUIRE, "agent");
            xb_add(&bar[XB_XGEN(b.x)], 1u);
            asm volatile("s_waitcnt vmcnt(0)" ::: "memory");
        } else {
            XB_SPIN(xb_ld(&bar[XB_XGEN(b.x)]) == gen, bar);
            __builtin_amdgcn_fence(__ATOMIC_ACQUIRE, "agent");
            asm volatile("s_waitcnt vmcnt(0)" ::: "memory");
        }
    }
    __syncthreads();
}

constexpr int NPHASE = 14;
__global__ void __launch_bounds__(512, 2) fwd_megakernel(KArgs a) {
    extern __shared__ __attribute__((aligned(16))) unsigned char lds_raw[];
    LAS unsigned char* lds = (LAS unsigned char*)lds_raw;
    cg::grid_group grid = cg::this_grid();
    const int lo = a.ph_lo, hi = a.ph_hi;
    volatile LAS unsigned* bst = (volatile LAS unsigned*)(lds + BAR_LDS_OFF);
    if (threadIdx.x < 4) bst[threadIdx.x] = 0u;
    __syncthreads();
    XcdBarrier bar = xcd_barrier_post((unsigned*)a.ws, bst);
#define TIDS int tid = threadIdx.x; asm volatile("" : "+v"(tid)); const int lane = tid & 63, wave = __builtin_amdgcn_readfirstlane(tid >> 6); (void)lane; (void)wave
    const int G = gridDim.x;
    const float* mod = (const float*)(a.ws + WS_MOD);
    bf16_t* HN = (bf16_t*)(a.ws + WS_HN);
    bf16_t* ACT = (bf16_t*)(a.ws + WS_PROJ);
    bf16_t* PROJ = (bf16_t*)(a.ws + WS_PROJ);
    bf16_t* XB = (bf16_t*)a.out + (size_t)M * DM;
    constexpr bool FUSE_NORM = true;
    bf16_t* XB2 = (bf16_t*)(a.ws + WS_CST);
    float* PART = (float*)(a.ws + WS_UT);
    float* XS4 = (float*)(a.ws + WS_XS); float* XS5 = XS4 + (size_t)MS * DM;
#define IN(k) (lo <= (k) && (k) < hi)
#define SEAM(k) do { if (IN(k) && IN((k) + 1)) xcd_barrier(bar); } while (0)
    if (lo < 0) grid.sync();

    if (IN(0)) for (int rep = 0; rep < (DBG_REP == 0 ? 2 : 1); ++rep) { if (rep) grid.sync(); { TIDS; phase_prologue(a, lds, tid, wave, lane); } }
    SEAM(0);
    if (IN(1)) for (int rep = 0; rep < (DBG_REP == 1 ? 2 : 1); ++rep) { if (rep) grid.sync(); { TIDS; phase_norm<false, 0, false>(a, a.x_prompt, nullptr, a.x_sample, nullptr, a.g_norm, 0 * DM, 1 * DM, 0, 0.f, 0, lds, tid, wave, lane); } }
    SEAM(1);
    if (IN(2)) for (int rep = 0; rep < (DBG_REP == 2 ? 2 : 1); ++rep) { if (rep) grid.sync(); { pg8::Gemm g{HN, (const bf16_t*)(a.ws + WS_WUP1), M, NUP, DM}; pg8::StaticOrder S; S.init(M, NUP, G, (int)blockIdx.x, DM);
        pg8::EpiSwiglu E{ACT}; pg8::gemm_phase<pg8::EpiSwiglu, pg8::StaticOrder, true, true>(lds, g, S, E);
        { TIDS; const int thr = S.nwg % G, c = (int)blockIdx.x; if (rep == 0 && c >= thr) convert_group(a, 1, (c - thr) * 8 + wave, (G - thr) * 8, lds, wave, lane); } } }
    SEAM(2);
    if (IN(3)) for (int rep = 0; rep < (DBG_REP == 3 ? 2 : 1); ++rep) { if (rep) grid.sync(); { pg8::Gemm g{ACT, (const bf16_t*)(a.ws + WS_WDN1), M, DM, DFF}; pg8::SplitOrder S; S.init(DM, G, (int)blockIdx.x, DFF, 4);
        pg8::EpiResidT<false> E{a.x_prompt, nullptr, XB, mod, 2 * DM, 0.5f, PART}; pg8::gemm_phase<pg8::EpiResidT<false>, pg8::SplitOrder, true, true>(lds, g, S, E);
        { TIDS; const int thr = (S.P.nwg + S.NS * (MS / 256) * S.P.nN) % G, c = (int)blockIdx.x; if (rep == 0 && c >= thr) convert_group(a, 2, (c - thr) * 8 + wave, (G - thr) * 8, lds, wave, lane); } } }
    SEAM(3);
    if (IN(4)) for (int rep = 0; rep < (DBG_REP == 4 ? 2 : 1); ++rep) { if (rep) grid.sync(); { TIDS; phase_norm<true, 4, true>(a, nullptr, XB, a.x_sample, XS5, a.g_norm + DM, 3 * DM, 4 * DM, 2 * DM, 0.5f, 0, lds, tid, wave, lane); } }
    SEAM(4);
    if (IN(5)) for (int rep = 0; rep < (DBG_REP == 5 ? 2 : 1); ++rep) { if (rep) grid.sync(); { pg8::Gemm g{HN, (const bf16_t*)(a.ws + WS_WIN), M, NPROJ, DM}; pg8::StaticOrder S; S.init(M, NPROJ, G, (int)blockIdx.x, DM);
        pg8::EpiProj E{PROJ, a.out}; pg8::gemm_phase<pg8::EpiProj, pg8::StaticOrder, true, true>(lds, g, S, E);
        { TIDS; (void)lane; (void)wave; const int thr = S.nwg % G, c = (int)blockIdx.x; if (rep == 0 && c >= thr) kvc_convert(a, (c - thr) * 512 + tid, (G - thr) * 512); } } }
    SEAM(5);
    if (IN(6)) for (int rep = 0; rep < (DBG_REP == 6 ? 2 : 1); ++rep) { if (rep) grid.sync(); { TIDS; phase_mixA(a, lds, tid, wave, lane); } }
    SEAM(6);
    if (IN(7)) for (int rep = 0; rep < (DBG_REP == 7 ? 2 : 1); ++rep) { if (rep) grid.sync(); { TIDS; LAS float* tab = (LAS float*)(lds + TAB_OFF); for (int i = tid; i < 8 * 256; i += 512) { const int e = i & 255; tab[i] = a.rel_tab[(i >> 8) * 192 + (e > 191 ? 191 : e)] * LOG2E; } __syncthreads();
        phase_scan(a, tid);
        const int nscan = (8 * (129 * 128 / 4) + 511) / 512;
        if ((int)blockIdx.x >= nscan && G > nscan) for (int it = (int)blockIdx.x - nscan; it < ATT_N7; it += G - nscan) attn_item(a, it, lds, wave, lane); } }
    SEAM(7);
    if (IN(8)) for (int rep = 0; rep < (DBG_REP == 8 ? 2 : 1); ++rep) { if (rep) grid.sync(); { TIDS; phase_mixC(a, lds, tid, wave, lane); } }
    SEAM(8);
    if (IN(9)) for (int rep = 0; rep < (DBG_REP == 9 ? 2 : 1); ++rep) { if (rep) grid.sync(); { pg8::Gemm g{HN, (const bf16_t*)(a.ws + WS_WOUT), M, DM, DM}; pg8::SplitOrder S; S.init(DM, G, (int)blockIdx.x, DM, 2);
        pg8::EpiResidT<true> E{nullptr, XB, XB2, mod, 5 * DM, 1.0f, PART}; pg8::gemm_phase<pg8::EpiResidT<true>, pg8::SplitOrder, true, true>(lds, g, S, E); } }
    SEAM(9);
    if (IN(10)) for (int rep = 0; rep < (DBG_REP == 10 ? 2 : 1); ++rep) { if (rep) grid.sync(); { TIDS; phase_norm<false, 2, true>(a, nullptr, XB2, XS5, XS4, a.g_norm + 2 * DM, 6 * DM, 7 * DM, 5 * DM, 1.0f, 0, lds, tid, wave, lane); } }
    SEAM(10);
    if (IN(11)) for (int rep = 0; rep < (DBG_REP == 11 ? 2 : 1); ++rep) { if (rep) grid.sync(); { pg8::Gemm g{HN, (const bf16_t*)(a.ws + WS_WUP2), M, NUP, DM}; pg8::StaticOrder S; S.init(M, NUP, G, (int)blockIdx.x, DM);
        pg8::EpiSwiglu E{ACT}; pg8::gemm_phase<pg8::EpiSwiglu, pg8::StaticOrder, true, true>(lds, g, S, E); } }
    SEAM(11);
    if (IN(12)) for (int rep = 0; rep < (DBG_REP == 12 ? 2 : 1); ++rep) { if (rep) grid.sync(); { pg8::Gemm g{ACT, (const bf16_t*)(a.ws + WS_WDN2), M, DM, DFF}; pg8::SplitOrder S; S.init(DM, G, (int)blockIdx.x, DFF, 4);
        pg8::EpiResidNorm<0> E{XB2, HN, (void*)a.out, mod, PART, a.g_final, a.ws}; pg8::gemm_phase<pg8::EpiResidNorm<0>, pg8::SplitOrder, true, true>(lds, g, S, E); } }
    SEAM(12);
    if (IN(13)) for (int rep = 0; rep < (DBG_REP == 13 ? 2 : 1); ++rep) { if (rep) grid.sync(); { TIDS; phase_final_norm(a, HN, XS4, FUSE_NORM ? MP : 0, wave, lane); } }

    if (DBG_REP == 100) { for (int r = 0; r < 13; ++r) grid.sync(); }
#undef IN
#undef SEAM
}

extern "C" void kernel_launch(void* const* d_in, const int* in_sizes, int n_in, void* d_out, int out_size, void* d_ws, size_t ws_size, hipStream_t stream) {
    static int grid = 0;
    if (grid == 0) {
        if (n_in != 25 || (size_t)out_size != OUT_TOTAL || ws_size < WS_END) { fprintf(stderr, "kernel_launch: unexpected shapes: n_in %d out %d ws %zu\n", n_in, out_size, ws_size); grid = -1; return; }
        int dev = 0, cus = 0, per_cu = 0;
        hipGetDevice(&dev);
        hipDeviceGetAttribute(&cus, hipDeviceAttributeMultiprocessorCount, dev);
        hipFuncSetAttribute((const void*)fwd_megakernel, hipFuncAttributeMaxDynamicSharedMemorySize, LDS_BYTES);
        hipOccupancyMaxActiveBlocksPerMultiprocessor(&per_cu, (const void*)fwd_megakernel, 512, LDS_BYTES);
        if (per_cu < 1) { fprintf(stderr, "kernel_launch: occupancy query says %d blocks per CU\n", per_cu); per_cu = 1; }
        (void)hipGetLastError();
        grid = cus * per_cu;
    }
    if (grid < 0) return;
    if (hipMemsetAsync(d_ws, 0, CTL_ZERO_BYTES, stream) != hipSuccess) { fprintf(stderr, "kernel_launch: memset failed\n"); return; }
    KArgs a{};
    const float** f = (const float**)&a;
    for (int i = 0; i < 25; ++i) f[i] = (const float*)d_in[i];
    a.out = (float*)d_out; a.ws = (unsigned char*)d_ws;
#if MK_MULTI
    hipMemsetAsync(d_out, 0, (size_t)out_size * 4, stream);
    for (int p = 0; p < DBG_NPH; ++p) {
        a.ph_lo = p; a.ph_hi = p + 1;
        void* args[] = {&a};
        hipError_t e = hipLaunchCooperativeKernel((const void*)fwd_megakernel, dim3(grid), dim3(512), args, LDS_BYTES, stream);
        if (e != hipSuccess) { fprintf(stderr, "launch %d failed: %s\n", p, hipGetErrorString(e)); break; }
    }
#else
    a.ph_lo = 0; a.ph_hi = NPHASE;
    void* args[] = {&a};
    hipError_t e = hipLaunchCooperativeKernel((const void*)fwd_megakernel, dim3(grid), dim3(512), args, LDS_BYTES, stream);
    if (e != hipSuccess) fprintf(stderr, "cooperative launch failed: %s (grid %d)\n", hipGetErrorString(e), grid);
#endif
}
```
